# Optimizing an MI355X kernel written in HIP

```python
import math
import jax, jax.numpy as jnp
from jax import lax
import numpy as np

D_MODEL = 1024
BATCH = 16
SEQ = 2048
DEPTH = 4

GRID_W = 64
CTX_LEN = 256
N_BRANCH = 4
BRANCH_W = D_MODEL // 2
RNN_W = BRANCH_W
RNN_BLOCK = 64
RNN_BLOCKS = RNN_W // RNN_BLOCK
RG_C = 8.0
CONV_W = 4
ATT_DIM = 64
ATT_HEADS = BRANCH_W // (2 * ATT_DIM)
ATT_QK_W = ATT_HEADS * 2 * ATT_DIM
ATT_V_W = ATT_HEADS * 2 * ATT_DIM
ROPE_F = ATT_DIM // 4
ROPE_BASE = 10000.0
Q_BLOCK = 128
POOL_W = BRANCH_W
POOL_WINDOWS = (2, 4, 8, 16)
POOL_GROUPS = len(POOL_WINDOWS)
POOL_GW = POOL_W // POOL_GROUPS
SSM_W = BRANCH_W
SSM_P = 64
SSM_HEADS = SSM_W // SSM_P
SSM_G = 2
SSM_N = 64
SSM_XBC_W = SSM_W + 2 * SSM_G * SSM_N
SSM_CHUNK = 128
N_EXPERTS = 32
TOP_K = 4
D_EXPERT = D_MODEL
SWIGLU_LIMIT = 7.0
SWIGLU_ALPHA = 1.702
EXPERT_BLOCK = 256
DN_ALPHA = (2 * DEPTH) ** 0.25
DN_BETA = (8 * DEPTH) ** -0.25
IN_WIDTHS = (RNN_W, RNN_W, ATT_QK_W, ATT_QK_W, ATT_V_W, POOL_W, SSM_W, SSM_XBC_W, 2 * SSM_HEADS, N_BRANCH * D_MODEL)
IN_W = sum(IN_WIDTHS)
IN_SPLITS = tuple(int(v) for v in np.cumsum(IN_WIDTHS)[:-1])

kernel_name = 'hybrid_diffusion_gated_mixers_moe'


def _normalize(x, eps=1e-6):
    xf = x.astype(jnp.float32)
    mu = jnp.mean(xf, -1, keepdims=True)
    var = jnp.mean(jnp.square(xf - mu), -1, keepdims=True)
    return ((xf - mu) * lax.rsqrt(var + eps)).astype(x.dtype)


def layer_norm(x, g, b):
    return _normalize(x, 1e-5) * g + b


def modulate(x, shift, scale):
    return _normalize(x) * (1.0 + scale) + shift


def centred_dwconv(u, w, b):
    length = u.shape[1]
    left = CONV_W // 2
    up = jnp.pad(u, ((0, 0), (left, CONV_W - 1 - left), (0, 0)))
    out = b + up[:, 0:length] * w[0]
    for k in range(1, CONV_W):
        out = out + up[:, k:k + length] * w[k]
    return out


def linear_recurrence(a, b, h0, reverse):
    def combine(left, right):
        a_l, b_l = left
        a_r, b_r = right
        return a_l * a_r, a_r * b_l + b_r
    a_cum, h = lax.associative_scan(combine, (a, b), reverse=reverse, axis=1)
    h = h + a_cum * h0[:, None]
    final = h[:, 0] if reverse else h[:, -1]
    return h, final


def rglru_coeffs(u, wa, ba, wx, bx, lam):
    bsz, length, width = u.shape
    ub = u.reshape(bsz, length, RNN_BLOCKS, RNN_BLOCK)
    r = jax.nn.sigmoid(jnp.einsum('blhi,hij->blhj', ub, wa).reshape(bsz, length, width) + ba)
    i = jax.nn.sigmoid(jnp.einsum('blhi,hij->blhj', ub, wx).reshape(bsz, length, width) + bx)
    log_a = -RG_C * r * jax.nn.softplus(-lam)
    a = jnp.exp(log_a)
    mult = jnp.sqrt(-jnp.expm1(2.0 * log_a))
    return a, mult * (i * u)


def rglru_branch(u_c, u_l, gate_c, gate_l, conv_w, conv_b, wa, ba, wx, bx, lam, need_ctx):
    dtype = u_l.dtype
    u_c = centred_dwconv(u_c, conv_w, conv_b).astype(jnp.float32)
    u_l = centred_dwconv(u_l, conv_w, conv_b).astype(jnp.float32)
    h0 = jnp.zeros((u_c.shape[0], RNN_W), jnp.float32)
    y_c = jnp.zeros_like(u_c)
    y_l = jnp.zeros_like(u_l)
    for d in range(2):
        rev = d == 1
        a_c, b_c = rglru_coeffs(u_c, wa[d], ba[d], wx[d], bx[d], lam[d])
        a_l, b_l = rglru_coeffs(u_l, wa[d], ba[d], wx[d], bx[d], lam[d])
        h_c, h_fin = linear_recurrence(a_c, b_c, h0, rev)
        h_l, _ = linear_recurrence(a_l, b_l, h_fin, rev)
        y_c = y_c + h_c
        y_l = y_l + h_l
    out_l = (jax.nn.gelu(gate_l.astype(jnp.float32)) * y_l).astype(dtype)
    out_c = (jax.nn.gelu(gate_c.astype(jnp.float32)) * y_c).astype(dtype) if need_ctx else None
    return out_l, out_c


def axial_rope_tables(n_lat):
    rows = n_lat // GRID_W
    row = jnp.repeat(jnp.arange(rows, dtype=jnp.float32), GRID_W)
    col = jnp.tile(jnp.arange(GRID_W, dtype=jnp.float32), rows)
    inv = ROPE_BASE ** (-jnp.arange(ROPE_F, dtype=jnp.float32) / ROPE_F)
    ang = jnp.stack([row[:, None] * inv, col[:, None] * inv], axis=1)
    return jnp.cos(ang), jnp.sin(ang)


def rope_2d(x, cos, sin):
    xs = x.astype(jnp.float32).reshape(*x.shape[:-1], 2, 2, ROPE_F)
    x1, x2 = xs[..., 0, :], xs[..., 1, :]
    cs = cos[None, :, None, None]
    sn = sin[None, :, None, None]
    out = jnp.stack([x1 * cs - x2 * sn, x2 * cs + x1 * sn], axis=-2)
    return out.reshape(x.shape).astype(x.dtype)


def diff_softmax_attend(q, k, v, lam):
    s = jnp.einsum('bqhcd,bkhcd->bhcqk', q, k).astype(jnp.float32) * (ATT_DIM ** -0.5)
    p = jax.nn.softmax(s, axis=-1)
    w = p[:, :, 0] - lam * p[:, :, 1]
    return jnp.einsum('bhqk,bkhe->bqhe', w.astype(v.dtype), v)


def diff_head_norm(o, subln_w, lam_init):
    bsz, length = o.shape[:2]
    of = o.astype(jnp.float32)
    of = of * lax.rsqrt(jnp.mean(jnp.square(of), -1, keepdims=True) + 1e-5) * subln_w * (1.0 - lam_init)
    return of.reshape(bsz, length, ATT_V_W).astype(o.dtype)


def diff_attention_branch(q_c, k_c, v_c, q_l, k_l, v_l, lam_vecs, subln_w, layer_idx, cos, sin, need_ctx):
    bsz, n_lat = q_l.shape[:2]
    n_ctx = k_c.shape[1]
    heads = lambda t: t.reshape(t.shape[0], t.shape[1], ATT_HEADS, 2, ATT_DIM)
    q_l = rope_2d(heads(q_l), cos, sin)
    k_l = rope_2d(heads(k_l), cos, sin)
    k_c = heads(k_c)
    v_l = v_l.reshape(bsz, n_lat, ATT_HEADS, 2 * ATT_DIM)
    v_c = v_c.reshape(bsz, n_ctx, ATT_HEADS, 2 * ATT_DIM)
    lam_init = 0.8 - 0.6 * math.exp(-0.3 * layer_idx)
    lv = lam_vecs.astype(jnp.float32)
    lam = jnp.exp(jnp.sum(lv[0] * lv[1])) - jnp.exp(jnp.sum(lv[2] * lv[3])) + lam_init
    k_all = jnp.concatenate([k_c, k_l], axis=1)
    v_all = jnp.concatenate([v_c, v_l], axis=1)
    n_blk = n_lat // Q_BLOCK
    qb = jnp.swapaxes(q_l.reshape(bsz, n_blk, Q_BLOCK, ATT_HEADS, 2, ATT_DIM), 0, 1)
    ob = lax.map(lambda qq: diff_softmax_attend(qq, k_all, v_all, lam), qb)
    o_l = jnp.swapaxes(ob, 0, 1).reshape(bsz, n_lat, ATT_HEADS, 2 * ATT_DIM)
    out_l = diff_head_norm(o_l, subln_w, lam_init)
    out_c = None
    if need_ctx:
        out_c = diff_head_norm(diff_softmax_attend(heads(q_c), k_c, v_c, lam), subln_w, lam_init)
    return out_l, out_c


def multiscale_pool(u, w, b, scale):
    bsz, length, _ = u.shape
    ug = u.astype(jnp.float32).reshape(bsz, length, POOL_GROUPS, POOL_GW)
    csum = jnp.pad(jnp.cumsum(ug, axis=1), ((0, 0), (1, 0), (0, 0), (0, 0)))
    t = jnp.arange(length)
    pooled = []
    for gi, win in enumerate(POOL_WINDOWS):
        lo = jnp.clip(t - win // 2, 0, length - 1)
        hi = jnp.clip(t + win - 1 - win // 2, 0, length - 1)
        cnt = (hi - lo + 1).astype(jnp.float32)[None, :, None]
        sg = csum[:, :, gi]
        pooled.append((sg[:, hi + 1] - sg[:, lo]) / cnt)
    mix = jnp.stack(pooled, axis=2) - ug
    y = jnp.einsum('blgc,gce->blge', mix, w).reshape(bsz, length, POOL_W) + b
    return (y * scale).astype(u.dtype)


def segsum(a):
    t = a.shape[-1]
    cs = jnp.cumsum(a, axis=-1)
    diff = cs[..., :, None] - cs[..., None, :]
    mask = jnp.tril(jnp.ones((t, t), dtype=bool))
    return jnp.where(mask, diff, -jnp.inf)


def ssd_scan(xdt, adt, bm, cm, h0):
    b, l, h, p = xdt.shape
    g, n = bm.shape[2], bm.shape[3]
    k = h // g
    c = l // SSM_CHUNK
    X = xdt.reshape(b, c, SSM_CHUNK, g, k, p)
    A = adt.reshape(b, c, SSM_CHUNK, g, k).transpose(0, 3, 4, 1, 2)
    Bc = bm.reshape(b, c, SSM_CHUNK, g, n)
    Cc = cm.reshape(b, c, SSM_CHUNK, g, n)
    a_cs = jnp.cumsum(A, axis=-1)
    lmat = jnp.exp(segsum(A))
    cb = jnp.einsum('bclgn,bcsgn->bgcls', Cc, Bc)
    y_diag = jnp.einsum('bgcls,bgkcls,bcsgkp->bclgkp', cb, lmat, X)
    decay_states = jnp.exp(a_cs[..., -1:] - a_cs)
    states = jnp.einsum('bclgn,bgkcl,bclgkp->bcgkpn', Bc, decay_states, X)
    states = jnp.concatenate([h0.reshape(b, g, k, p, n)[:, None], states], axis=1)
    chunk_a = jnp.pad(a_cs[..., -1], ((0, 0), (0, 0), (0, 0), (1, 0)))
    decay_chunk = jnp.exp(segsum(chunk_a))
    new_states = jnp.einsum('bgkzc,bcgkpn->bzgkpn', decay_chunk, states)
    prev_states, final = new_states[:, :-1], new_states[:, -1]
    y_off = jnp.einsum('bclgn,bcgkpn,bgkcl->bclgkp', Cc, prev_states, jnp.exp(a_cs))
    y = (y_diag + y_off).reshape(b, l, h, p)
    return y, final.reshape(b, h, p, n)


def ssd_prep(xbc, conv_w, conv_b):
    b, l, _ = xbc.shape
    u = jax.nn.silu(centred_dwconv(xbc, conv_w, conv_b).astype(jnp.float32))
    xs, bm, cm = jnp.split(u, (SSM_W, SSM_W + SSM_G * SSM_N), axis=-1)
    return (xs.reshape(b, l, SSM_HEADS, SSM_P), bm.reshape(b, l, SSM_G, SSM_N), cm.reshape(b, l, SSM_G, SSM_N))


def ssd_direction(xs, bm, cm, dt_raw, dt_bias, a_log, d_skip, h0, reverse):
    dt = jax.nn.softplus(dt_raw.astype(jnp.float32) + dt_bias)
    a = -jnp.exp(a_log.astype(jnp.float32))
    xdt = xs * dt[..., None]
    adt = dt * a
    if reverse:
        xdt, adt, bm, cm = (jnp.flip(t, axis=1) for t in (xdt, adt, bm, cm))
    y, h_fin = ssd_scan(xdt, adt, bm, cm, h0)
    if reverse:
        y = jnp.flip(y, axis=1)
    return y + d_skip[:, None] * xs, h_fin


def gated_rmsnorm(y, z, w):
    b, l = y.shape[:2]
    g = (y.reshape(b, l, SSM_W) * jax.nn.silu(z.astype(jnp.float32))).reshape(b, l, SSM_G, SSM_W // SSM_G)
    g = g * lax.rsqrt(jnp.mean(jnp.square(g), -1, keepdims=True) + 1e-5)
    return g.reshape(b, l, SSM_W) * w


def ssd_branch(z_c, xbc_c, dt_c, z_l, xbc_l, dt_l, conv_w, conv_b, dt_bias, a_log, d_skip, norm_w, need_ctx):
    dtype = z_l.dtype
    xs_c, b_c, c_c = ssd_prep(xbc_c, conv_w, conv_b)
    xs_l, b_l, c_l = ssd_prep(xbc_l, conv_w, conv_b)
    h0 = jnp.zeros((xs_c.shape[0], SSM_HEADS, SSM_P, SSM_N), jnp.float32)
    y_c = jnp.zeros_like(xs_c)
    y_l = jnp.zeros_like(xs_l)
    for d in range(2):
        sl = slice(d * SSM_HEADS, (d + 1) * SSM_HEADS)
        yc_d, h_fin = ssd_direction(xs_c, b_c, c_c, dt_c[..., sl], dt_bias[d], a_log[d], d_skip[d], h0, d == 1)
        yl_d, _ = ssd_direction(xs_l, b_l, c_l, dt_l[..., sl], dt_bias[d], a_log[d], d_skip[d], h_fin, d == 1)
        y_c = y_c + yc_d
        y_l = y_l + yl_d
    out_l = gated_rmsnorm(y_l, z_l, norm_w).astype(dtype)
    out_c = gated_rmsnorm(y_c, z_c, norm_w).astype(dtype) if need_ctx else None
    return out_l, out_c


def merge_branches(ys, gates_raw, w_branch, w_out):
    b, l, _ = gates_raw.shape
    g = jax.nn.sigmoid(gates_raw.astype(jnp.float32)).reshape(b, l, N_BRANCH, D_MODEL).astype(gates_raw.dtype)
    m = g[:, :, 0] * (ys[0] @ w_branch[0])
    for i in range(1, N_BRANCH):
        m = m + g[:, :, i] * (ys[i] @ w_branch[i])
    return m @ w_out


def moe_ffn(h, router_w, router_b, w_gate_up, b_gate_up, w_down, b_down):
    n, d = h.shape
    logits = (h @ router_w + router_b).astype(jnp.float32)
    top_logit, top_e = lax.top_k(logits, TOP_K)
    probs = jax.nn.softmax(top_logit, axis=-1)
    a = n * TOP_K
    flat_e = top_e.reshape(a)
    flat_tok = jnp.arange(a, dtype=jnp.int32) // TOP_K
    flat_p = probs.reshape(a)
    order = jnp.argsort(flat_e)
    se = flat_e[order]
    counts = jnp.bincount(flat_e, length=N_EXPERTS)
    pcounts = (counts + EXPERT_BLOCK - 1) // EXPERT_BLOCK * EXPERT_BLOCK
    start = jnp.cumsum(counts) - counts
    pend = jnp.cumsum(pcounts)
    pstart = pend - pcounts
    dest = pstart[se] + jnp.arange(a, dtype=jnp.int32) - start[se]
    n_blocks = -(-a // EXPERT_BLOCK) + N_EXPERTS
    slots = n_blocks * EXPERT_BLOCK
    slot_tok = jnp.full((slots,), n, jnp.int32).at[dest].set(flat_tok[order])
    slot_p = jnp.zeros((slots,), jnp.float32).at[dest].set(flat_p[order])
    block_e = jnp.minimum(jnp.searchsorted(pend // EXPERT_BLOCK, jnp.arange(n_blocks), side='right'), N_EXPERTS - 1)
    h_pad = jnp.concatenate([h, jnp.zeros((1, d), h.dtype)], axis=0)
    xb = h_pad[slot_tok].reshape(n_blocks, EXPERT_BLOCK, d)

    def expert_block(args):
        xe, e = args
        gu = xe @ w_gate_up[e] + b_gate_up[e]
        gate, up = gu[:, :D_EXPERT], gu[:, D_EXPERT:]
        gate = jnp.minimum(gate, SWIGLU_LIMIT)
        up = jnp.clip(up, -SWIGLU_LIMIT, SWIGLU_LIMIT)
        glu = gate * jax.nn.sigmoid(gate * SWIGLU_ALPHA)
        return ((up + 1.0) * glu) @ w_down[e] + b_down[e]

    yb = lax.map(expert_block, (xb, block_e)).reshape(slots, d)
    out = jnp.zeros((n + 1, d), yb.dtype).at[slot_tok].add(yb * slot_p[:, None].astype(yb.dtype))
    return out[:n]


def setup_inputs(seed: int = 0) -> dict:
    key = jax.random.key(seed)
    it = iter(jax.random.split(key, 64))
    nrm = lambda shape, scale: jax.random.normal(next(it), shape, jnp.float32) * scale
    D, L = D_MODEL, DEPTH
    a0 = jax.random.uniform(next(it), (L, 2, RNN_W), jnp.float32, 0.9, 0.999)
    s0 = a0 ** (1.0 / RG_C)
    dt0 = jnp.exp(jax.random.uniform(next(it), (L, 2, SSM_HEADS), jnp.float32, math.log(1e-3), math.log(1e-1)))
    return {
        'x': nrm((BATCH, SEQ, D), 1.0),
        'c': nrm((BATCH, D), 1.0),
        'ctx': nrm((BATCH, CTX_LEN, D), 1.0),
        'c_ctx': nrm((D,), 1.0),
        'w_ada': nrm((L, D, 6 * D), 0.5 * D ** -0.5),
        'b_ada': nrm((L, 6 * D), 0.02),
        'w_in': nrm((L, D, IN_W), D ** -0.5),
        'rnn_conv_w': nrm((L, CONV_W, RNN_W), CONV_W ** -0.5),
        'rnn_conv_b': nrm((L, RNN_W), 0.02),
        'rnn_wa': nrm((L, 2, RNN_BLOCKS, RNN_BLOCK, RNN_BLOCK), RNN_BLOCK ** -0.5),
        'rnn_ba': nrm((L, 2, RNN_W), 0.02),
        'rnn_wx': nrm((L, 2, RNN_BLOCKS, RNN_BLOCK, RNN_BLOCK), RNN_BLOCK ** -0.5),
        'rnn_bx': nrm((L, 2, RNN_W), 0.02),
        'rnn_lam': jnp.log(s0) - jnp.log1p(-s0),
        'att_lambda': nrm((L, 4, ATT_DIM), 0.1),
        'att_subln': 1.0 + nrm((L, 2 * ATT_DIM), 0.02),
        'pool_w': nrm((L, POOL_GROUPS, POOL_GW, POOL_GW), POOL_GW ** -0.5),
        'pool_b': nrm((L, POOL_W), 0.02),
        'pool_scale': 1.0 + nrm((L, POOL_W), 0.02),
        'ssm_conv_w': nrm((L, CONV_W, SSM_XBC_W), CONV_W ** -0.5),
        'ssm_conv_b': nrm((L, SSM_XBC_W), 0.02),
        'ssm_dt_bias': dt0 + jnp.log(-jnp.expm1(-dt0)),
        'ssm_a_log': jnp.log(jax.random.uniform(next(it), (L, 2, SSM_HEADS), jnp.float32, 1.0, 16.0)),
        'ssm_d': 1.0 + nrm((L, 2, SSM_HEADS), 0.02),
        'ssm_norm': 1.0 + nrm((L, SSM_W), 0.02),
        'w_branch': nrm((L, N_BRANCH, BRANCH_W, D), BRANCH_W ** -0.5),
        'w_out': nrm((L, D, D), DN_BETA * D ** -0.5),
        'ln1_g': 1.0 + nrm((L, D), 0.02),
        'ln1_b': nrm((L, D), 0.02),
        'ln2_g': 1.0 + nrm((L, D), 0.02),
        'ln2_b': nrm((L, D), 0.02),
        'router_w': nrm((L, D, N_EXPERTS), D ** -0.5),
        'router_b': nrm((L, N_EXPERTS), 0.01),
        'w_gate_up': nrm((L, N_EXPERTS, D, 2 * D_EXPERT), D ** -0.5),
        'b_gate_up': nrm((L, N_EXPERTS, 2 * D_EXPERT), 0.02),
        'w_down': nrm((L, N_EXPERTS, D_EXPERT, D), DN_BETA * D_EXPERT ** -0.5),
        'b_down': nrm((L, N_EXPERTS, D), 0.02),
    }


def reference(x, c, ctx, c_ctx, w_ada, b_ada, w_in, rnn_conv_w, rnn_conv_b, rnn_wa, rnn_ba, rnn_wx, rnn_bx, rnn_lam, att_lambda, att_subln, pool_w, pool_b, pool_scale, ssm_conv_w, ssm_conv_b, ssm_dt_bias, ssm_a_log, ssm_d, ssm_norm, w_branch, w_out, ln1_g, ln1_b, ln2_g, ln2_b, router_w, router_b, w_gate_up, b_gate_up, w_down, b_down):
    n_lat = x.shape[1]
    cos, sin = axial_rope_tables(n_lat)
    xl, xc = x, ctx
    for li in range(DEPTH):
        need_ctx = li < DEPTH - 1
        mod_l = (jax.nn.silu(c) @ w_ada[li] + b_ada[li])[:, None, :]
        mod_c = (jax.nn.silu(c_ctx) @ w_ada[li] + b_ada[li])[None, None, :]
        sh1, sc1, g1, sh2, sc2, g2 = jnp.split(mod_l, 6, axis=-1)
        csh1, csc1, cg1, csh2, csc2, cg2 = jnp.split(mod_c, 6, axis=-1)

        hl = modulate(xl, sh1, sc1)
        hc = modulate(xc, csh1, csc1)
        (rx_l, rg_l, q_l, k_l, v_l, pu_l, z_l, xbc_l, dt_l, mg_l) = jnp.split(hl @ w_in[li], IN_SPLITS, axis=-1)
        (rx_c, rg_c, q_c, k_c, v_c, pu_c, z_c, xbc_c, dt_c, mg_c) = jnp.split(hc @ w_in[li], IN_SPLITS, axis=-1)
        rnn_l, rnn_c = rglru_branch(rx_c, rx_l, rg_c, rg_l, rnn_conv_w[li], rnn_conv_b[li], rnn_wa[li], rnn_ba[li], rnn_wx[li], rnn_bx[li], rnn_lam[li], need_ctx)
        att_l, att_c = diff_attention_branch(q_c, k_c, v_c, q_l, k_l, v_l, att_lambda[li], att_subln[li], li, cos, sin, need_ctx)
        pool_l = multiscale_pool(pu_l, pool_w[li], pool_b[li], pool_scale[li])
        ssm_l, ssm_c = ssd_branch(z_c, xbc_c, dt_c, z_l, xbc_l, dt_l, ssm_conv_w[li], ssm_conv_b[li], ssm_dt_bias[li], ssm_a_log[li], ssm_d[li], ssm_norm[li], need_ctx)
        y_l = merge_branches((rnn_l, att_l, pool_l, ssm_l), mg_l, w_branch[li], w_out[li])
        if need_ctx:
            pool_c = multiscale_pool(pu_c, pool_w[li], pool_b[li], pool_scale[li])
            y_c = merge_branches((rnn_c, att_c, pool_c, ssm_c), mg_c, w_branch[li], w_out[li])
            xc = layer_norm(DN_ALPHA * xc + cg1 * y_c, ln1_g[li], ln1_b[li])
        xl = layer_norm(DN_ALPHA * xl + g1 * y_l, ln1_g[li], ln1_b[li])

        hl2 = modulate(xl, sh2, sc2).reshape(-1, D_MODEL)
        if need_ctx:
            hc2 = modulate(xc, csh2, csc2).reshape(-1, D_MODEL)
            f = moe_ffn(jnp.concatenate([hc2, hl2], axis=0), router_w[li], router_b[li], w_gate_up[li], b_gate_up[li], w_down[li], b_down[li])
            f_c, f_l = f[:hc2.shape[0]], f[hc2.shape[0]:]
            xc = layer_norm(DN_ALPHA * xc + cg2 * f_c.reshape(xc.shape), ln2_g[li], ln2_b[li])
        else:
            f_l = moe_ffn(hl2, router_w[li], router_b[li], w_gate_up[li], b_gate_up[li], w_down[li], b_down[li])
        xl = layer_norm(DN_ALPHA * xl + g2 * f_l.reshape(xl.shape), ln2_g[li], ln2_b[li])
    return xl
```

```cpp
#include <hip/hip_runtime.h>
#include <cstdio>
#include <cstdint>

#ifndef MK_N_LAUNCHES
#define MK_N_LAUNCHES 1
#endif

#define GAS __attribute__((address_space(1)))
#define LAS __attribute__((address_space(3)))
typedef unsigned short bf16_t;
typedef short bf16x8 __attribute__((ext_vector_type(8)));
typedef short s16x4 __attribute__((ext_vector_type(4)));
typedef float f32x2 __attribute__((ext_vector_type(2)));
typedef float f32x4 __attribute__((ext_vector_type(4)));
typedef float f32x16 __attribute__((ext_vector_type(16)));
typedef unsigned u32x2 __attribute__((ext_vector_type(2)));
typedef unsigned u32x4 __attribute__((ext_vector_type(4)));

constexpr int D = 1024, NBATCH = 16, SEQ = 2048, CTXL = 256, DEPTH = 4;
constexpr int NCTX = NBATCH * CTXL;
constexpr int NLAT = NBATCH * SEQ;
constexpr int NTOK = NCTX + NLAT;
constexpr int PW = 8448;
constexpr int C_RX = 0, C_RG = 512, C_Q = 1024, C_K = 1536, C_V = 2048, C_PU = 2560, C_Z = 3072, C_XBC = 3584, C_MG = 4352;
constexpr int INW = 8464;
constexpr int NEXP = 32, ECAP = NTOK;
constexpr int NSLOT = NTOK * 4 + NEXP * 256;
constexpr float DN_ALPHA = 1.6817928305074290f;
constexpr int NWAVES = 8, NTHREADS = 512;
constexpr float QSCALE = 0.125f * 1.4426950408889634f;

constexpr size_t al256(size_t x) { return (x + 255) & ~(size_t)255; }
constexpr size_t WS_CTL = 0, CTL_BYTES = 1u << 20;
constexpr size_t WS_MOD = WS_CTL + CTL_BYTES;
constexpr size_t WS_ROPE = WS_MOD + al256((size_t)DEPTH * 17 * 6144 * 4);
constexpr size_t WS_WDT = WS_ROPE + 8192;
constexpr size_t WS_ROUT = WS_WDT + (size_t)DEPTH * 16 * 1024 * 4;
constexpr size_t WS_WIN = WS_ROUT + (size_t)DEPTH * 32 * 1024 * 4;
constexpr size_t WS_WGU = WS_WIN + (size_t)DEPTH * PW * 1024 * 2;
constexpr size_t WS_WD = WS_WGU + (size_t)DEPTH * 32 * 2048 * 1024 * 2;
constexpr size_t WS_WBR = WS_WD + (size_t)DEPTH * 32 * 1024 * 1024 * 2;
constexpr size_t WS_WOUT = WS_WBR + (size_t)DEPTH * 4 * 1024 * 512 * 2;
constexpr size_t WS_POOLW = WS_WOUT + (size_t)DEPTH * 1024 * 1024 * 2;
constexpr size_t WS_RNNW = WS_POOLW + (size_t)DEPTH * 4 * 128 * 128 * 2;
constexpr size_t WS_XL = WS_RNNW + (size_t)DEPTH * 2 * 2 * 8 * 64 * 64 * 2;
constexpr size_t WS_H = WS_XL + (size_t)NTOK * 1024 * 4;
constexpr size_t WS_PROJ = WS_H + (size_t)NTOK * 1024 * 2;
constexpr size_t WS_DT = WS_PROJ + (size_t)NTOK * PW * 2;
constexpr size_t WS_HF = WS_DT + (size_t)NTOK * 16 * 4;
constexpr size_t WS_HB = WS_HF + (size_t)NTOK * 512 * 4;
constexpr size_t WS_YF = WS_HB + (size_t)NTOK * 512 * 4;
constexpr size_t WS_YB = WS_YF + (size_t)NTOK * 512 * 4;
constexpr size_t WS_YS = WS_YB + (size_t)NTOK * 512 * 4;
constexpr size_t WS_MACC = WS_YS + (size_t)NTOK * 2048 * 2;
constexpr size_t WS_M = WS_MACC + (size_t)NTOK * 1024 * 4;
constexpr size_t WS_EP = WS_M + (size_t)NTOK * 1024 * 2;
constexpr size_t WS_ELIST = WS_EP + (size_t)NTOK * 4 * 4;
constexpr size_t WS_XG = WS_ELIST + (size_t)NEXP * ECAP * 4;
constexpr size_t WS_HID = WS_XG + (size_t)NSLOT * 1024 * 2;
constexpr size_t WS_Y2 = WS_HID + (size_t)NSLOT * 1024 * 2;
constexpr size_t WS_ATT = WS_Y2 + (size_t)NTOK * 4 * 1024 * 2;
constexpr size_t WS_END = WS_ATT + (size_t)256 * 16 * 512 * 16;
constexpr int CW_BAR = 4096;
constexpr int CW_ECNT = 16384;
constexpr int CW_QHEAD = 32768;

constexpr int SCR_BYTES = 131072;
constexpr int XTRA_OFF = SCR_BYTES;
constexpr int MISC_OFF = SCR_BYTES + 15872;
constexpr int XTRA2_OFF = 147456;
constexpr int LDS_BYTES = 163840;

__device__ __forceinline__ float bf2f(bf16_t b) { return __uint_as_float(((unsigned)b) << 16); }
__device__ __forceinline__ unsigned cvt_pk_bf16(float lo, float hi) { unsigned r; asm volatile("v_cvt_pk_bf16_f32 %0, %1, %2" : "=v"(r) : "v"(lo), "v"(hi)); return r; }
__device__ __forceinline__ bf16_t f2bf(float f) { return (bf16_t)(cvt_pk_bf16(f, 0.f) & 0xffffu); }
__device__ __forceinline__ float lo_bf(unsigned w) { return __uint_as_float(w << 16); }
__device__ __forceinline__ float hi_bf(unsigned w) { return __uint_as_float(w & 0xffff0000u); }
__device__ __forceinline__ float sigmoidf_(float x) { return __builtin_amdgcn_rcpf(1.0f + __builtin_amdgcn_exp2f(-1.4426950408889634f * x)); }
__device__ __forceinline__ float siluf_(float x) { return x * __builtin_amdgcn_rcpf(1.0f + __builtin_amdgcn_exp2f(-1.4426950408889634f * x)); }
__device__ __forceinline__ float softplusf_(float x) { const float e = __expf(x); return x > 20.f ? x : (e < 1e-4f ? e * (1.0f - 0.5f * e) : __logf(1.0f + e)); }
__device__ __forceinline__ float gelu_tanh(float x) { const float u = 0.7978845608028654f * (x + 0.044715f * x * x * x); const float e = __builtin_amdgcn_exp2f(2.8853900817779268f * u); const float t = 1.f - 2.f * __builtin_amdgcn_rcpf(e + 1.f); return 0.5f * x * (1.f + t); }
__device__ __forceinline__ f32x4 sig4_(f32x4 t) { f32x4 e; _Pragma("unroll") for (int j = 0; j < 4; ++j) e[j] = __builtin_amdgcn_exp2f(t[j]); e = e + 1.0f; f32x4 r; _Pragma("unroll") for (int j = 0; j < 4; ++j) r[j] = __builtin_amdgcn_rcpf(e[j]); return r; }
__device__ __forceinline__ f32x4 silu4_(f32x4 x) { return x * sig4_(x * -1.4426950408889634f); }
__device__ __forceinline__ f32x4 gelu4_(f32x4 x) { const f32x4 x2 = x * x; return x * sig4_(x * (x2 * (-2.0f * 0.7978845608028654f * 0.044715f * 1.4426950408889634f) + (-2.0f * 0.7978845608028654f * 1.4426950408889634f))); }
__device__ __forceinline__ f32x4 bf4lo_(u32x4 v) { return (f32x4){lo_bf(v.x), hi_bf(v.x), lo_bf(v.y), hi_bf(v.y)}; }
__device__ __forceinline__ f32x4 bf4hi_(u32x4 v) { return (f32x4){lo_bf(v.z), hi_bf(v.z), lo_bf(v.w), hi_bf(v.w)}; }
__device__ __forceinline__ int shxi(int v, int o, int lane) {
    if (__builtin_constant_p(o)) {
        if (o == 32) { const auto rr = __builtin_amdgcn_permlane32_swap((unsigned)v, (unsigned)v, false, false); return (lane & 32) ? (int)rr[0] : (int)rr[1]; }
        if (o == 16) { const auto rr = __builtin_amdgcn_permlane16_swap((unsigned)v, (unsigned)v, false, false); return (lane & 16) ? (int)rr[0] : (int)rr[1]; }
        if (o == 8) return __builtin_amdgcn_update_dpp(0, v, 0x140, 0xf, 0xf, true);
        if (o == 4) return __builtin_amdgcn_update_dpp(0, v, 0x141, 0xf, 0xf, true);
        if (o == 2) return __builtin_amdgcn_update_dpp(0, v, 0x4E, 0xf, 0xf, true);
        if (o == 1) return __builtin_amdgcn_update_dpp(0, v, 0xB1, 0xf, 0xf, true);
    }
    return __builtin_amdgcn_ds_bpermute((lane ^ o) << 2, v);
}
__device__ __forceinline__ float shx(float v, int o, int lane) { return __int_as_float(shxi(__float_as_int(v), o, lane)); }
__device__ __forceinline__ float shl_(float v, int src_lane) { return __int_as_float(__builtin_amdgcn_ds_bpermute(src_lane << 2, __float_as_int(v))); }
__device__ __forceinline__ float wave_sum(float v, int lane) {
#pragma unroll
    for (int o = 1; o < 64; o <<= 1) v += shx(v, o, lane);
    return v;
}
template <int H, int OFF, int NN> __device__ __forceinline__ void bfly_rec(float (&p)[NN], int lane) {
    if constexpr (H >= 1) {
        const bool up = (lane & OFF) != 0;
#pragma unroll
        for (int i = 0; i < H; ++i) { const float keep = up ? p[H + i] : p[i]; const float send = up ? p[i] : p[H + i]; p[i] = keep + shx(send, OFF, lane); }
        bfly_rec<H / 2, OFF / 2, NN>(p, lane);
    }
}
template <int N> __device__ __forceinline__ float bfly_reduce(float (&p)[N], int lane) {
    bfly_rec<N / 2, 32, N>(p, lane);
    float v = p[0];
#pragma unroll
    for (int off = (64 / N) / 2; off >= 1; off >>= 1) v += shx(v, off, lane);
    return v;
}

#define XB_TMO      128
#define XB_XCNT(j)  (256  + 64 * (j))
#define XB_XSUB(j)  (1280 + 64 * (j))
#define XB_XGEN(j)  (2304 + 64 * (j))
#define XB_TOP      3328
#define XB_TOPGEN   3392
#define XCD_BAR_WORDS 3456
#define XB_SPIN_CAP (1u << 20)
__device__ __forceinline__ unsigned xb_ld(unsigned* p)              { return __hip_atomic_load(p, __ATOMIC_RELAXED, __HIP_MEMORY_SCOPE_AGENT); }
__device__ __forceinline__ unsigned xb_add(unsigned* p, unsigned v) { return __hip_atomic_fetch_add(p, v, __ATOMIC_RELAXED, __HIP_MEMORY_SCOPE_AGENT); }
__device__ __forceinline__ unsigned xb_xcc_id() { return (unsigned)__builtin_amdgcn_s_getreg((3 << 11) | 20) & 0xFu; }
#define XB_SPIN(cond, bar) do { unsigned _sp = 0; while (cond) { __builtin_amdgcn_s_sleep(1); \
    if ((++_sp & 255u) == 0u) { if (xb_ld(&(bar)[XB_TMO])) break; if (_sp > XB_SPIN_CAP) { atomicAdd(&(bar)[XB_TMO], 1u); break; } } } } while (0)
struct XcdBarrier { unsigned* bar; unsigned x; volatile LAS unsigned* st; };
__device__ __forceinline__ XcdBarrier xcd_barrier_post(unsigned* bar, volatile LAS unsigned* st) {
    XcdBarrier b; b.bar = bar; b.x = xb_xcc_id(); b.st = st;
    if (threadIdx.x == 0) (void)xb_add(&bar[XB_XCNT(b.x)], 1u);
    return b;
}
__device__ __forceinline__ void xcd_barrier_complete(unsigned* bar, unsigned x, unsigned& nloc, unsigned& nx) {
    const unsigned G = gridDim.x * gridDim.y * gridDim.z;
    unsigned sum, cnt, mine, sp = 0u;
    for (;;) {
        sum = 0u; cnt = 0u; mine = 0u;
#pragma unroll
        for (unsigned j = 0; j < 16; ++j) { const unsigned c = xb_ld(&bar[XB_XCNT(j)]); sum += c; cnt += (c > 0u) ? 1u : 0u; mine = (j == x) ? c : mine; }
        if (sum == G) break;
        __builtin_amdgcn_s_sleep(1);
        if ((++sp & 255u) == 0u) { if (xb_ld(&bar[XB_TMO])) break; if (sp > XB_SPIN_CAP) { atomicAdd(&bar[XB_TMO], 1u); break; } }
    }
    nloc = mine > 0u ? mine : 1u; nx = cnt > 0u ? cnt : 1u;
}
__device__ __forceinline__ void xcd_barrier(const XcdBarrier& b) {
    asm volatile("s_waitcnt vmcnt(0)" ::: "memory");
    __syncthreads();
    if (threadIdx.x == 0) {
        unsigned* bar = b.bar;
        __builtin_amdgcn_s_waitcnt(0);
        unsigned nloc = b.st[0], nx = b.st[1];
        if (nloc == 0u) { xcd_barrier_complete(bar, b.x, nloc, nx); b.st[0] = nloc; b.st[1] = nx; }
        const unsigned old = xb_add(&bar[XB_XSUB(b.x)], 1u);
        const unsigned gen = old / nloc;
        if (old + 1u == (gen + 1u) * nloc) {
            __builtin_amdgcn_fence(__ATOMIC_RELEASE, "agent");
            asm volatile("s_waitcnt vmcnt(0)" ::: "memory");
            const unsigned og = xb_add(&bar[XB_TOP], 1u);
            const unsigned tg = og / nx;
            if (og + 1u == (tg + 1u) * nx) xb_add(&bar[XB_TOPGEN], 1u);
            else XB_SPIN(xb_ld(&bar[XB_TOPGEN]) == tg, bar);
            __builtin_amdgcn_fence(__ATOMIC_ACQUIRE, "agent");
            xb_add(&bar[XB_XGEN(b.x)], 1u);
            asm volatile("s_waitcnt vmcnt(0)" ::: "memory");
        } else {
            XB_SPIN(xb_ld(&bar[XB_XGEN(b.x)]) == gen, bar);
            __builtin_amdgcn_fence(__ATOMIC_ACQUIRE, "agent");
            asm volatile("s_waitcnt vmcnt(0)" ::: "memory");
        }
    }
    __syncthreads();
}

struct Frame {
    LAS unsigned char* lds;
    int G, bid;
    const float* const* in;
    float* out; unsigned char* ws;
};
#define WSP(T, off) ((T*)(F.ws + (off)))
#define LAUNDER_V(x) asm volatile("" : "+v"(x))
#define LAUNDER_S(x) asm volatile("" : "+s"(x))

namespace pg8 {
constexpr int BM = 256, BK = 64, HALF = 128, HTB = HALF * BK * 2, STAGE_BYTES = 8 * HTB, NXCD = 8, WGM = 8;
__host__ __device__ __forceinline__ int lds_byte(int r, int c) { const int st = (r >> 4) * 2 + (c >> 5), rr = r & 15, cc = c & 31, ob = rr * 64 + cc * 2; return st * 1024 + (ob ^ (((ob >> 9) & 1) << 5)); }
__host__ __device__ __forceinline__ void stage_rc(int b, int& R, int& C) { const int st = b / 1024, sb = b % 1024, swz = sb ^ (((sb >> 9) & 1) << 5); R = (st >> 1) * 16 + swz / 64; C = (st & 1) * 32 + (swz % 64) / 2; }
__host__ __device__ __forceinline__ int perm32(int rho) { const int n = rho >> 4, i = rho & 15; return 8 * (i >> 2) + 4 * n + (i & 3); }

struct Unit { const char* a; const char* b; int pm, pn, e, aux; };
__device__ __forceinline__ void tile_of(int L, int nM, int nN, int& pm, int& pn) {
    const int nwg = nM * nN; int wgid = L; { const int q = nwg / NXCD, r = nwg % NXCD, xcd = wgid % NXCD, off = wgid / NXCD; wgid = (xcd < r ? xcd * (q + 1) : r * (q + 1) + (xcd - r) * q) + off; }
    const int nig = WGM * nN, gid = wgid / nig, fm = gid * WGM, gsz = (nM - fm) < WGM ? (nM - fm) : WGM;
    pm = fm + ((wgid % nig) % gsz); pn = (wgid % nig) / gsz;
}

template <class Epi, class Sched, bool QUAD = false>
__device__ __forceinline__ void gemm_phase(LAS unsigned char* lds, const int K, const unsigned lda, const unsigned ldb, const Sched& S, const Epi& E) {
    int tid = threadIdx.x; LAUNDER_V(tid);
    const int wid = __builtin_amdgcn_readfirstlane(tid >> 6), lane = tid & 63, wr = wid >> 2, wc = wid & 3, fr = lane & 15, fq = lane >> 4;
    const int nt = K / BK;
    unsigned voffB[2]; int sR[2], sC[2];
#pragma unroll
    for (int i = 0; i < 2; ++i) { int R, C; stage_rc(tid * 16 + i * 8192, R, C); const int Rb = Epi::PERM ? ((R & ~31) + perm32(R & 31)) : R;
        sR[i] = R; sC[i] = C; voffB[i] = (unsigned)Rb * ldb + (unsigned)C * 2u; }
    unsigned voffA[2][2];
    const size_t kstep = (size_t)(BK * 2);
    const size_t hstepB = S.hstep_b(ldb);
    const unsigned ldsw = (unsigned)wid * 1024u;
    const int aoff = lds_byte(wr * 64 + fr, fq * 8), boff = lds_byte(wc * 32 + fr, fq * 8);
#define PG8_SA(b, h) (((b) * 2 + (h)) * HTB)
#define PG8_SB(b, h) ((4 + (b) * 2 + (h)) * HTB)
#define PG8_STAGE(bufoff, gbase, voff) do { _Pragma("unroll") for (int _i = 0; _i < 2; ++_i) \
        __builtin_amdgcn_global_load_lds((const unsigned*)((const char*)(gbase) + (voff)[_i]), (LAS unsigned*)(lds + (bufoff) + ldsw + _i * 8192), 16, 0, 0); } while (0)
#define PG8_LDA(dst, b, h) do { _Pragma("unroll") for (int m = 0; m < 4; ++m) _Pragma("unroll") for (int k = 0; k < 2; ++k) dst[m][k] = *(const LAS bf16x8*)(lds + PG8_SA(b, h) + aoff + m * 2048 + k * 1024); } while (0)
#define PG8_LDB(dst, b, h) do { _Pragma("unroll") for (int n = 0; n < 2; ++n) _Pragma("unroll") for (int k = 0; k < 2; ++k) dst[n][k] = *(const LAS bf16x8*)(lds + PG8_SB(b, h) + boff + n * 2048 + k * 1024); } while (0)
#define PG8_MMA(ai, bj, At, Bt) do { __builtin_amdgcn_s_setprio(1); _Pragma("unroll") for (int m = 0; m < 4; ++m) _Pragma("unroll") for (int n = 0; n < 2; ++n) _Pragma("unroll") for (int k = 0; k < 2; ++k) \
        acc[ai][bj][m][n] = __builtin_amdgcn_mfma_f32_16x16x32_bf16(Bt[n][k], At[m][k], acc[ai][bj][m][n], 0, 0, 0); __builtin_amdgcn_s_setprio(0); } while (0)
#define PG8_WAIT_V(n) asm volatile("s_waitcnt vmcnt(" #n ")" ::: "memory")
#define PG8_WAIT_L(n) asm volatile("s_waitcnt lgkmcnt(" #n ")" ::: "memory")
#define PG8_BAR __builtin_amdgcn_s_barrier()
#define PG8_SCHED __builtin_amdgcn_sched_barrier(0)
    Unit cur, nxt; int ui = 0;
    if (!S.next(0, cur)) return;
    f32x4 acc[2][2][4][2];
#pragma unroll
    for (int a = 0; a < 2; ++a)
#pragma unroll
        for (int b = 0; b < 2; ++b)
#pragma unroll
            for (int m = 0; m < 4; ++m)
#pragma unroll
                for (int n = 0; n < 2; ++n) acc[a][b][m][n] = (f32x4){0.f, 0.f, 0.f, 0.f};
    bf16x8 At[4][2], B0[2][2], B1[2][2];
    const char* cA = cur.a; const char* cB = cur.b;
    S.aoff(cur, sR, sC, lda, voffA);
    PG8_STAGE(PG8_SB(0, 0), cB, voffB); PG8_STAGE(PG8_SB(0, 1), cB + hstepB, voffB); PG8_STAGE(PG8_SA(0, 0), cA, voffA[0]); PG8_STAGE(PG8_SA(0, 1), cA, voffA[1]);
    if (wr == 1) PG8_BAR;
    PG8_WAIT_V(2); PG8_BAR;
    PG8_STAGE(PG8_SB(1, 0), cB + kstep, voffB); PG8_STAGE(PG8_SA(1, 0), cA + kstep, voffA[0]); PG8_STAGE(PG8_SB(1, 1), cB + hstepB + kstep, voffB);
    PG8_WAIT_V(6); PG8_BAR;
    for (;;) {
        const bool has_next = S.next(ui + 1, nxt);
        const char* nA = has_next ? nxt.a : cA; const char* nB = has_next ? nxt.b : cB;
#define PG8_TRIP(MMA_A0, MMA_A1) { \
            const bool last = (t == nt - 2); \
            const char* a1 = cA + (size_t)(t + 1) * kstep; \
            const char* a2 = last ? nA : cA + (size_t)(t + 2) * kstep; const char* b2 = last ? nB : cB + (size_t)(t + 2) * kstep; \
            const char* a3 = a2 + kstep; const char* b3 = b2 + kstep; \
            PG8_LDB(B0, 0, 0); PG8_LDB(B1, 0, 1); PG8_SCHED; PG8_LDA(At, 0, 0); PG8_STAGE(PG8_SA(1, 1), a1, voffA[1]); \
            if (last && has_next) S.aoff(nxt, sR, sC, lda, voffA);     \
            PG8_WAIT_V(8); PG8_WAIT_L(0); PG8_BAR; MMA_A0; PG8_BAR; PG8_SCHED; \
            PG8_LDA(At, 0, 1); PG8_STAGE(PG8_SB(0, 0), b2, voffB); PG8_STAGE(PG8_SB(0, 1), b2 + hstepB, voffB); PG8_STAGE(PG8_SA(0, 0), a2, voffA[0]); \
            PG8_WAIT_V(8); PG8_WAIT_L(0); PG8_BAR; MMA_A1; PG8_BAR; PG8_SCHED; \
            PG8_LDB(B0, 1, 0); PG8_LDB(B1, 1, 1); PG8_SCHED; PG8_LDA(At, 1, 0); PG8_STAGE(PG8_SA(0, 1), a2, voffA[1]); \
            PG8_WAIT_V(8); PG8_WAIT_L(0); PG8_BAR; MMA_A0; PG8_BAR; PG8_SCHED; \
            PG8_LDA(At, 1, 1); PG8_STAGE(PG8_SB(1, 0), b3, voffB); PG8_STAGE(PG8_SB(1, 1), b3 + hstepB, voffB); PG8_STAGE(PG8_SA(1, 0), a3, voffA[0]); \
            PG8_WAIT_V(8); PG8_WAIT_L(0); PG8_BAR; MMA_A1; PG8_BAR; PG8_SCHED; }
        if constexpr (!QUAD) {
            for (int t = 0; t < nt; t += 2) PG8_TRIP({ PG8_MMA(0, 0, At, B0); PG8_MMA(0, 1, At, B1); }, { PG8_MMA(1, 0, At, B0); PG8_MMA(1, 1, At, B1); })
        } else {
            int t = 0;
            for (; 2 * t < nt; t += 2) PG8_TRIP({ PG8_MMA(0, 0, At, B0); }, { PG8_MMA(1, 1, At, B1); })
            for (; t < nt; t += 2) PG8_TRIP({ PG8_MMA(0, 1, At, B1); }, { PG8_MMA(1, 0, At, B0); })
        }
#undef PG8_TRIP
        if (wr == 0) PG8_BAR;
        E(acc, cur, wr, wc, fr, fq);
        if (!has_next) break;
#pragma unroll
        for (int a = 0; a < 2; ++a)
#pragma unroll
            for (int b = 0; b < 2; ++b)
#pragma unroll
                for (int m = 0; m < 4; ++m)
#pragma unroll
                    for (int n = 0; n < 2; ++n) acc[a][b][m][n] = (f32x4){0.f, 0.f, 0.f, 0.f};
        cur = nxt; cA = nA; cB = nB; ++ui;
        if (wr == 1) PG8_BAR;
    }
    PG8_WAIT_V(0);
    PG8_BAR;
#undef PG8_SA
#undef PG8_SB
#undef PG8_STAGE
#undef PG8_LDA
#undef PG8_LDB
#undef PG8_MMA
#undef PG8_WAIT_V
#undef PG8_WAIT_L
#undef PG8_BAR
#undef PG8_SCHED
}
}

struct SchedGrid {
    int nM, nN, G, c, pm0; const char* A; const char* B; size_t ta, tb;
    __device__ __forceinline__ size_t hstep_b(unsigned ldb) const { return (size_t)128 * ldb; }
    __device__ __forceinline__ bool next(int i, pg8::Unit& u) const {
        const long L = (long)i * G + c; if (L >= (long)nM * nN) return false;
        int pm, pn; pg8::tile_of((int)L, nM, nN, pm, pn); pm += pm0;
        u.pm = pm; u.pn = pn; u.e = 0; u.aux = 0; u.a = A + (size_t)pm * ta; u.b = B + (size_t)pn * tb; return true;
    }
    __device__ __forceinline__ void aoff(const pg8::Unit&, const int (&R)[2], const int (&C)[2], unsigned lda, unsigned (&vo)[2][2]) const {
#pragma unroll
        for (int h = 0; h < 2; ++h)
#pragma unroll
            for (int i = 0; i < 2; ++i) vo[h][i] = (unsigned)(h * 128 + R[i]) * lda + (unsigned)C[i] * 2u; }
};
struct SchedQuad {
    int nM, nN, G, c, tm0; const char* A; const char* B;
    __device__ __forceinline__ size_t hstep_b(unsigned) const { return (size_t)1024 * 2048; }
    __device__ __forceinline__ bool next(int i, pg8::Unit& u) const {
        const long L = (long)i * G + c; if (L >= (long)nM * nN) return false;
        int tm, tn; pg8::tile_of((int)L, nM, nN, tm, tn); tm += tm0;
        u.pm = tm; u.pn = tn; u.e = 0; u.aux = 0; u.a = A + (size_t)tm * 128 * 4096; u.b = B + (size_t)tn * 128 * 2048; return true;
    }
    __device__ __forceinline__ void aoff(const pg8::Unit&, const int (&R)[2], const int (&C)[2], unsigned lda, unsigned (&vo)[2][2]) const {
#pragma unroll
        for (int h = 0; h < 2; ++h)
#pragma unroll
            for (int i = 0; i < 2; ++i) vo[h][i] = (unsigned)R[i] * lda + (unsigned)(h * 1024 + C[i]) * 2u; }
};
__device__ __forceinline__ bool moe_unit(int i, int c, int G, int nN, int total, int& mtg, int& pn) {
    const int per = G >> 3, x = c & 7, r = c >> 3;
    if ((G & 7) != 0 || r >= per) { const long L = (long)i * G + c; mtg = (int)(L / nN); pn = (int)(L % nN); return mtg < total; }
    const int n = i * per + r; mtg = x + 8 * (n / nN); pn = n % nN; return mtg < total;
}
struct SchedMoe {
    const LAS int* tstart; const LAS unsigned short* toks; int nN, G, c; const char* A; const char* B; size_t ta, tb, eb;
    __device__ __forceinline__ size_t hstep_b(unsigned ldb) const { return (size_t)128 * ldb; }
    __device__ __forceinline__ bool next(int i, pg8::Unit& u) const {
        const int total = tstart[32]; int mtg, pn;
        if (!moe_unit(i, c, G, nN, total, mtg, pn)) return false;
        int e = 0;
#pragma unroll 1
        for (int k = 1; k < 32; ++k) e += (tstart[k] <= mtg) ? 1 : 0;
        u.pm = mtg; u.pn = pn; u.e = e; u.aux = (mtg - tstart[e]) | (i << 16);
        u.a = A + (size_t)mtg * ta; u.b = B + (size_t)e * eb + (size_t)pn * tb; return true;
    }
    __device__ __forceinline__ void aoff(const pg8::Unit& u, const int (&R)[2], const int (&C)[2], unsigned lda, unsigned (&vo)[2][2]) const {
        const int ord = u.aux >> 16;
#pragma unroll
        for (int h = 0; h < 2; ++h)
#pragma unroll
            for (int i = 0; i < 2; ++i) { const unsigned row = toks ? (unsigned)toks[ord * 256 + h * 128 + R[i]] : (unsigned)(h * 128 + R[i]); vo[h][i] = row * lda + (unsigned)C[i] * 2u; }
    }
};

struct EpiProj {
    static constexpr bool PERM = true;
    bf16_t* O; const float* rcos; const float* rsin; unsigned char* g8;
    __device__ __forceinline__ void operator()(const f32x4 (&acc)[2][2][4][2], const pg8::Unit& u, int wr, int wc, int fr, int fq) const {
        const int row0 = u.pm * 256 + wr * 64 + fr, col0 = u.pn * 256 + wc * 32 + 8 * fq;
        if (u.pn >= C_MG / 256) {
#pragma unroll
            for (int ai = 0; ai < 2; ++ai)
#pragma unroll
                for (int m = 0; m < 4; ++m) {
                    unsigned char* rowp = g8 + (size_t)(row0 + ai * 128 + m * 16) * 4096 + (col0 - C_MG);
#pragma unroll
                    for (int bj = 0; bj < 2; ++bj) {
                        unsigned q[8];
#pragma unroll
                        for (int n = 0; n < 2; ++n) {
                            const f32x4 tt = acc[ai][bj][m][n] * -1.4426950408889634f; f32x4 ee, rr;
#pragma unroll
                            for (int j = 0; j < 4; ++j) ee[j] = __builtin_amdgcn_exp2f(tt[j]);
                            ee = ee + 1.0f;
#pragma unroll
                            for (int j = 0; j < 4; ++j) rr[j] = __builtin_amdgcn_rcpf(ee[j]);
                            rr = rr * 255.0f + 0.5f;
#pragma unroll
                            for (int j = 0; j < 4; ++j) q[4 * n + j] = (unsigned)rr[j]; }
                        u32x2 w; w.x = q[0] | (q[1] << 8) | (q[2] << 16) | (q[3] << 24); w.y = q[4] | (q[5] << 8) | (q[6] << 16) | (q[7] << 24);
                        *(u32x2*)(rowp + bj * 128) = w;
                    }
                }
            return;
        }
        const bool qk = (u.pn >= 4) && (u.pn < 8) && (u.pm >= 16);
        const bool isq = (u.pn == 4) || (u.pn == 5);
        const float sgn = (fq < 2) ? -1.f : 1.f;
#pragma unroll
        for (int ai = 0; ai < 2; ++ai)
#pragma unroll
            for (int m = 0; m < 4; ++m) {
                const int row = row0 + ai * 128 + m * 16;
                f32x4 c0 = {1.f, 1.f, 1.f, 1.f}, c1 = c0, s0 = {0.f, 0.f, 0.f, 0.f}, s1 = s0;
                if (qk) { const int t = (row - NCTX) & (SEQ - 1); const int p = (wc & 1) ? (t & 63) : (t >> 6); const int f0 = p * 16 + 8 * (fq & 1);
                    c0 = *(const f32x4*)(rcos + f0); c1 = *(const f32x4*)(rcos + f0 + 4); s0 = *(const f32x4*)(rsin + f0); s1 = *(const f32x4*)(rsin + f0 + 4); }
                bf16_t* rowp = O + (size_t)row * PW + col0;
#pragma unroll
                for (int bj = 0; bj < 2; ++bj) {
                    f32x4 v0 = acc[ai][bj][m][0], v1 = acc[ai][bj][m][1];
                    if (qk) {
                        f32x4 p0, p1;
#pragma unroll
                        for (int j = 0; j < 4; ++j) { p0[j] = shx(v0[j], 32, fq * 16 + fr); p1[j] = shx(v1[j], 32, fq * 16 + fr); }
                        v0 = v0 * c0 + (p0 * s0) * sgn; v1 = v1 * c1 + (p1 * s1) * sgn;
                    }
                    if (isq) { v0 = v0 * QSCALE; v1 = v1 * QSCALE; }
                    u32x4 w; w.x = cvt_pk_bf16(v0[0], v0[1]); w.y = cvt_pk_bf16(v0[2], v0[3]); w.z = cvt_pk_bf16(v1[0], v1[1]); w.w = cvt_pk_bf16(v1[2], v1[3]);
                    *(u32x4*)(rowp + bj * 128) = w;
                }
                __builtin_amdgcn_sched_barrier(0);
            }
    }
};
struct EpiQuad {
    static constexpr bool PERM = false;
    const unsigned char* g8; bf16_t* mout;
    __device__ __forceinline__ void operator()(const f32x4 (&acc)[2][2][4][2], const pg8::Unit& u, int wr, int wc, int fr, int fq) const {
        const int row0 = u.pm * 128 + wr * 64 + fr, col0 = u.pn * 128 + wc * 32 + 4 * fq;
#pragma unroll
        for (int mh = 0; mh < 2; ++mh) {
            unsigned g4[2][2][4];
#pragma unroll
            for (int mm = 0; mm < 2; ++mm)
#pragma unroll
                for (int n = 0; n < 2; ++n)
#pragma unroll
                    for (int br = 0; br < 4; ++br) g4[mm][n][br] = *(const unsigned*)(g8 + (size_t)(row0 + (2 * mh + mm) * 16) * 4096 + col0 + n * 16 + br * 1024);
            asm volatile("" ::: "memory");
#pragma unroll
            for (int mm = 0; mm < 2; ++mm) {
                const int m = 2 * mh + mm, row = row0 + m * 16;
#pragma unroll
                for (int n = 0; n < 2; ++n) {
                    const int col = col0 + n * 16;
                    f32x4 v = {0.f, 0.f, 0.f, 0.f};
#pragma unroll
                    for (int br = 0; br < 4; ++br) {
                        const f32x4 p = (br == 0) ? acc[0][0][m][n] : (br == 1) ? acc[1][1][m][n] : (br == 2) ? acc[0][1][m][n] : acc[1][0][m][n];
                        const unsigned gw = g4[mm][n][br];
                        f32x4 g; g[0] = (float)(gw & 255u); g[1] = (float)((gw >> 8) & 255u); g[2] = (float)((gw >> 16) & 255u); g[3] = (float)(gw >> 24);
                        v += g * p;
                    }
                    v = v * (1.0f / 255.0f);
                    u32x2 w; w.x = cvt_pk_bf16(v[0], v[1]); w.y = cvt_pk_bf16(v[2], v[3]); *(u32x2*)(mout + (size_t)row * 1024 + col) = w;
                }
            }
        }
    }
};
struct EpiOut {
    static constexpr bool PERM = true;
    bf16_t* yb; const float* mod;
    __device__ __forceinline__ void operator()(const f32x4 (&acc)[2][2][4][2], const pg8::Unit& u, int wr, int wc, int fr, int fq) const {
        const int row0 = u.pm * 256 + wr * 64 + fr, col0 = u.pn * 256 + wc * 32 + 8 * fq;
        const int mr = (u.pm < 16) ? 16 : ((u.pm - 16) >> 3);
        const float* gp = mod + (size_t)mr * 6144 + 2048 + col0;
        f32x4 g[2][2];
#pragma unroll
        for (int bj = 0; bj < 2; ++bj) { g[bj][0] = *(const f32x4*)(gp + bj * 128); g[bj][1] = *(const f32x4*)(gp + bj * 128 + 4); }
#pragma unroll
        for (int ai = 0; ai < 2; ++ai)
#pragma unroll
            for (int m = 0; m < 4; ++m) {
                bf16_t* rowp = yb + (size_t)(row0 + ai * 128 + m * 16) * 1024 + col0;
#pragma unroll
                for (int bj = 0; bj < 2; ++bj) { const f32x4 v0 = acc[ai][bj][m][0] * g[bj][0], v1 = acc[ai][bj][m][1] * g[bj][1];
                    u32x4 w; w.x = cvt_pk_bf16(v0[0], v0[1]); w.y = cvt_pk_bf16(v0[2], v0[3]); w.z = cvt_pk_bf16(v1[0], v1[1]); w.w = cvt_pk_bf16(v1[2], v1[3]);
                    *(u32x4*)(rowp + bj * 128) = w; }
            }
    }
};
struct EpiGU {
    static constexpr bool PERM = true;
    bf16_t* hid; const float* bgu;
    __device__ __forceinline__ void operator()(const f32x4 (&acc)[2][2][4][2], const pg8::Unit& u, int wr, int wc, int fr, int fq) const {
        const int row0 = u.pm * 256 + wr * 64 + fr, hc0 = u.pn * 128 + wc * 32 + 8 * fq;
        const float* bp = bgu + (size_t)u.e * 2048 + hc0;
        const f32x4 bg0 = *(const f32x4*)bp, bg1 = *(const f32x4*)(bp + 4), bu0 = *(const f32x4*)(bp + 1024), bu1 = *(const f32x4*)(bp + 1028);
#pragma unroll
        for (int ai = 0; ai < 2; ++ai)
#pragma unroll
            for (int m = 0; m < 4; ++m) {
                const int row = row0 + ai * 128 + m * 16;
                f32x4 o[2];
#pragma unroll
                for (int n = 0; n < 2; ++n) {
                    const f32x4 g = acc[ai][0][m][n] + (n ? bg1 : bg0), up = acc[ai][1][m][n] + (n ? bu1 : bu0);
                    f32x4 gg, uu;
#pragma unroll
                    for (int j = 0; j < 4; ++j) { gg[j] = fminf(g[j], 7.f); uu[j] = fminf(fmaxf(up[j], -7.f), 7.f); }
                    const f32x4 tt = gg * (-1.702f * 1.4426950408889634f);
                    f32x4 ee;
#pragma unroll
                    for (int j = 0; j < 4; ++j) ee[j] = __builtin_amdgcn_exp2f(tt[j]);
                    ee = ee + 1.0f;
                    f32x4 rr;
#pragma unroll
                    for (int j = 0; j < 4; ++j) rr[j] = __builtin_amdgcn_rcpf(ee[j]);
                    o[n] = (uu + 1.0f) * (gg * rr);
                }
                u32x4 w; w.x = cvt_pk_bf16(o[0][0], o[0][1]); w.y = cvt_pk_bf16(o[0][2], o[0][3]); w.z = cvt_pk_bf16(o[1][0], o[1][1]); w.w = cvt_pk_bf16(o[1][2], o[1][3]);
                *(u32x4*)(hid + (size_t)row * 1024 + hc0) = w;
            }
    }
};
struct EpiDown {
    static constexpr bool PERM = true;
    unsigned char* y2; const float* bd; const int* elist; const unsigned* ecnt;
    __device__ __forceinline__ void operator()(const f32x4 (&acc)[2][2][4][2], const pg8::Unit& u, int wr, int wc, int fr, int fq) const {
        const int lr0 = wr * 64 + fr, col0 = u.pn * 256 + wc * 32 + 8 * fq;
        const int cnt = (int)ecnt[u.e * 64]; const int pos0 = (u.aux & 0xffff) * 256;
        const float* bp = bd + (size_t)u.e * 1024 + col0;
        f32x4 b[2][2];
#pragma unroll
        for (int bj = 0; bj < 2; ++bj) { b[bj][0] = *(const f32x4*)(bp + bj * 128); b[bj][1] = *(const f32x4*)(bp + bj * 128 + 4); }
        int tk[2][4];
#pragma unroll
        for (int ai = 0; ai < 2; ++ai)
#pragma unroll
            for (int m = 0; m < 4; ++m) { const int pos = pos0 + lr0 + ai * 128 + m * 16; tk[ai][m] = elist[(size_t)u.e * ECAP + (pos < cnt ? pos : 0)]; }
        asm volatile("" ::: "memory");
#pragma unroll
        for (int ai = 0; ai < 2; ++ai)
#pragma unroll
            for (int m = 0; m < 4; ++m) {
                const int pos = pos0 + lr0 + ai * 128 + m * 16;
                if (pos < cnt) {
                    const int tok4 = tk[ai][m];
                    unsigned char* rowp = y2 + (size_t)tok4 * 1024 + col0;
#pragma unroll
                    for (int bj = 0; bj < 2; ++bj) {
                        const f32x4 v0 = acc[ai][bj][m][0] + b[bj][0], v1 = acc[ai][bj][m][1] + b[bj][1];
                        u32x2 w; int t0 = __builtin_amdgcn_cvt_pk_fp8_f32(v0[0], v0[1], 0, false); t0 = __builtin_amdgcn_cvt_pk_fp8_f32(v0[2], v0[3], t0, true);
                        int t1 = __builtin_amdgcn_cvt_pk_fp8_f32(v1[0], v1[1], 0, false); t1 = __builtin_amdgcn_cvt_pk_fp8_f32(v1[2], v1[3], t1, true);
                        w.x = (unsigned)t0; w.y = (unsigned)t1; *(u32x2*)(rowp + bj * 128) = w;
                    }
                }
            }
    }
};

#define LDS_WAIT() asm volatile("s_waitcnt lgkmcnt(0)" ::: "memory")
#define LDS_BARRIER() asm volatile("s_waitcnt lgkmcnt(0)\n\ts_barrier" ::: "memory")
__device__ __forceinline__ void tr_item(const float* W, int ldn, int K, bf16_t* WT, int k0, int n0s, int r0, LAS float* scr, int lane, int kd0 = 0) {
    const int l15 = lane & 15, l4 = lane >> 4;
    const float* src = W + (size_t)(k0 + l4) * ldn + n0s + 4 * l15;
    f32x4 v[16];
#pragma unroll
    for (int i = 0; i < 16; ++i) v[i] = *(const f32x4*)(src + (size_t)(4 * i) * ldn);
    asm volatile("" ::: "memory");
#pragma unroll
    for (int i = 0; i < 16; ++i) { LAS float* d = scr + (4 * l15) * 65 + 4 * i + l4; d[0] = v[i][0]; d[65] = v[i][1]; d[130] = v[i][2]; d[195] = v[i][3]; }
    LDS_WAIT(); asm volatile("" ::: "memory");
    const int c = lane & 7;
#pragma unroll
    for (int j = 0; j < 8; ++j) { const int n = (lane >> 3) + 8 * j; const LAS float* s = scr + n * 65 + 8 * c;
        u32x4 o; o.x = cvt_pk_bf16(s[0], s[1]); o.y = cvt_pk_bf16(s[2], s[3]); o.z = cvt_pk_bf16(s[4], s[5]); o.w = cvt_pk_bf16(s[6], s[7]);
        *(u32x4*)(WT + (size_t)(r0 + n) * K + kd0 + k0 + 8 * c) = o; }
    LDS_WAIT(); asm volatile("" ::: "memory");
}
__device__ __forceinline__ void p0_weights(Frame& F) {
    int tid_ = threadIdx.x; LAUNDER_V(tid_); const int lane_ = tid_ & 63, wave_ = __builtin_amdgcn_readfirstlane(tid_ >> 6); (void)lane_; (void)wave_;
    for (int task = F.bid; task < DEPTH * 4 * 16; task += F.G) {
        const int kb = task & 15, g = (task >> 4) & 3, li = task >> 6;
        LAS float* wl = (LAS float*)F.lds;
        LAS float* pl = wl + 64 * 129;
        const float* wsrc = F.in[6] + ((size_t)li * 1024 + kb * 64) * INW + C_PU + g * 128; const float* psrc = F.in[16] + (size_t)(li * 4 + g) * 128 * 128;
        f32x4 wv[4], pv[8];
#pragma unroll
        for (int i = 0; i < 4; ++i) wv[i] = *(const f32x4*)(wsrc + (size_t)((tid_ >> 5) + 16 * i) * INW + 4 * (tid_ & 31));
#pragma unroll
        for (int i = 0; i < 8; ++i) pv[i] = *(const f32x4*)(psrc + (size_t)(tid_ + 512 * i) * 4);
#pragma unroll
        for (int i = 0; i < 4; ++i) { LAS float* d = wl + ((tid_ >> 5) + 16 * i) * 129 + 4 * (tid_ & 31); d[0] = wv[i][0]; d[1] = wv[i][1]; d[2] = wv[i][2]; d[3] = wv[i][3]; }
#pragma unroll
        for (int i = 0; i < 8; ++i) *(LAS f32x4*)(pl + (tid_ + 512 * i) * 4) = pv[i];
        __syncthreads();
        const int k = tid_ & 63, eb = wave_;
        f32x4 a0 = {0.f, 0.f, 0.f, 0.f}, a1 = a0, a2 = a0, a3 = a0;
#pragma unroll 4
        for (int c = 0; c < 128; ++c) { const float w = wl[k * 129 + c]; const LAS f32x4* p = (const LAS f32x4*)(pl + c * 128 + eb * 16);
            a0 += p[0] * w; a1 += p[1] * w; a2 += p[2] * w; a3 += p[3] * w; }
        bf16_t* dst = WSP(bf16_t, WS_WIN) + ((size_t)li * PW + C_PU + g * 128 + eb * 16) * 1024 + kb * 64 + k;
#pragma unroll
        for (int j = 0; j < 4; ++j) { dst[(size_t)j * 1024] = f2bf(a0[j]); dst[(size_t)(4 + j) * 1024] = f2bf(a1[j]); dst[(size_t)(8 + j) * 1024] = f2bf(a2[j]); dst[(size_t)(12 + j) * 1024] = f2bf(a3[j]); }
        __syncthreads();
    }
    LAS float* scr = (LAS float*)(F.lds + wave_ * 16640);
    const int gw = F.bid * NWAVES + wave_, NGW = F.G * NWAVES, lane = lane_;
    constexpr int I_IN = 16 * (PW / 64), I_GU = 16 * 32, I_DN = 16 * 16, I_BR = 8 * 16, I_OUT = 16 * 16, I_RNN = 1;
    constexpr int N_IN = DEPTH * I_IN, N_GU = DEPTH * 32 * I_GU, N_DN = DEPTH * 32 * I_DN, N_BR = DEPTH * 4 * I_BR, N_OUT = DEPTH * I_OUT, N_RNN = DEPTH * 2 * 8 * I_RNN;
    constexpr int NITEMS = N_IN + N_GU + N_DN + N_BR + N_OUT + 2 * N_RNN;
    for (int it = gw; it < NITEMS; it += NGW) {
        int r = it;
        if (r < N_GU) { const int mat = r / I_GU, q = r % I_GU, kb = q / 32, rb = q % 32; const int r0 = rb * 64; const int pn = r0 >> 8, half = (r0 >> 7) & 1, jj = r0 & 127;
            tr_item(F.in[33] + (size_t)mat * 1024 * 2048, 2048, 1024, WSP(bf16_t, WS_WGU) + (size_t)mat * 2048 * 1024, kb * 64, half * 1024 + pn * 128 + jj, r0, scr, lane); continue; } r -= N_GU;
        if (r < N_DN) { const int mat = r / I_DN, q = r % I_DN, kb = q / 16, rb = q % 16;
            tr_item(F.in[35] + (size_t)mat * 1024 * 1024, 1024, 1024, WSP(bf16_t, WS_WD) + (size_t)mat * 1024 * 1024, kb * 64, rb * 64, rb * 64, scr, lane); continue; } r -= N_DN;
        if (r < N_IN) { const int mat = r / I_IN, q = r % I_IN, kb = q / (PW / 64), rb = q % (PW / 64); const int r0 = rb * 64;
            if (r0 >= C_PU && r0 < C_PU + 512) continue;
            tr_item(F.in[6] + (size_t)mat * 1024 * INW, INW, 1024, WSP(bf16_t, WS_WIN) + (size_t)mat * PW * 1024, kb * 64, r0 < C_MG ? r0 : r0 + 16, r0, scr, lane); continue; } r -= N_IN;
        if (r < N_BR) { const int mat = r / I_BR, q = r % I_BR, kb = q / 16, rb = q % 16;
            { const int lay = mat >> 2, br = mat & 3; const int hq = (br == 1 || br == 2) ? 1 : 0, sq = (br >= 2) ? 1 : 0;
              tr_item(F.in[25] + (size_t)mat * 512 * 1024, 1024, 1024, WSP(bf16_t, WS_WBR) + ((size_t)lay * 2 + hq) * 1024 * 1024, kb * 64, rb * 64, rb * 64, scr, lane, sq * 512); } continue; } r -= N_BR;
        if (r < N_OUT) { const int mat = r / I_OUT, q = r % I_OUT, kb = q / 16, rb = q % 16;
            tr_item(F.in[26] + (size_t)mat * 1024 * 1024, 1024, 1024, WSP(bf16_t, WS_WOUT) + (size_t)mat * 1024 * 1024, kb * 64, rb * 64, rb * 64, scr, lane); continue; } r -= N_OUT;
        {
            const int gate = r / N_RNN; r %= N_RNN; const int mat = r; const int ld = mat / 8, h = mat % 8;
            tr_item(F.in[gate ? 11 : 9] + (size_t)mat * 64 * 64, 64, 64, WSP(bf16_t, WS_RNNW) + ((size_t)(ld * 2 + gate) * 8 + h) * 64 * 64, 0, 0, 0, scr, lane);
        }
    }
    const int gt = F.bid * NTHREADS + tid_, NGT = F.G * NTHREADS;
    for (int i = gt; i < DEPTH * 16 * 1024; i += NGT) { const int li = i >> 14, j = (i >> 10) & 15, k = i & 1023; WSP(float, WS_WDT)[i] = F.in[6][((size_t)li * 1024 + k) * INW + C_MG + j]; }
    for (int i = gt; i < DEPTH * 32 * 1024; i += NGT) { const int li = i >> 15, e = (i >> 10) & 31, k = i & 1023; WSP(float, WS_ROUT)[i] = F.in[31][((size_t)li * 1024 + k) * 32 + e]; }
    for (int i = gt; i < 64 * 16; i += NGT) { const int p = i >> 4, f = i & 15; const float inv = powf(10000.0f, -(float)f / 16.0f); const float ang = (float)p * inv;
        WSP(float, WS_ROPE)[i] = cosf(ang); WSP(float, WS_ROPE)[1024 + i] = sinf(ang); }
}
__device__ __forceinline__ void p0_mod(Frame& F) {
    int tid_ = threadIdx.x; LAUNDER_V(tid_); const int lane_ = tid_ & 63, wave_ = __builtin_amdgcn_readfirstlane(tid_ >> 6); (void)lane_; (void)wave_;
    __syncthreads();
    LAS float* sc = (LAS float*)F.lds;
    LAS float* red = sc + 17440;
    for (int i = tid_; i < 17 * 1024; i += NTHREADS) { const int r = i >> 10, k = i & 1023; const float v = r < 16 ? F.in[1][r * 1024 + k] : F.in[3][k]; sc[r * 1025 + k] = siluf_(v); }
    __syncthreads();
    const int m = lane_ & 31, kk = lane_ >> 5;
    for (int cb = F.bid; cb < 256; cb += F.G) {
        const int li = cb >> 6, j0 = (cb & 63) * 96;
        f32x16 acc0, acc1, acc2;
#pragma unroll
        for (int j = 0; j < 16; ++j) { acc0[j] = 0.f; acc1[j] = 0.f; acc2[j] = 0.f; }
        const float* wp = F.in[4] + ((size_t)li * 1024 + wave_ * 128 + kk) * 6144 + j0 + m;
        const LAS float* ap = sc + (m < 17 ? m : 0) * 1025 + wave_ * 128 + kk;
#pragma unroll 1
        for (int kb = 0; kb < 64; kb += 16) {
            float w0[16], w1[16], w2[16], av[16];
#pragma unroll
            for (int i = 0; i < 16; ++i) { const float* p = wp + (size_t)(2 * (kb + i)) * 6144; w0[i] = p[0]; w1[i] = p[32]; w2[i] = p[64]; }
#pragma unroll
            for (int i = 0; i < 16; ++i) { const float a = ap[2 * (kb + i)]; av[i] = m < 17 ? a : 0.f; }
#pragma unroll
            for (int i = 0; i < 16; ++i) {
                acc0 = __builtin_amdgcn_mfma_f32_32x32x2f32(av[i], w0[i], acc0, 0, 0, 0);
                acc1 = __builtin_amdgcn_mfma_f32_32x32x2f32(av[i], w1[i], acc1, 0, 0, 0);
                acc2 = __builtin_amdgcn_mfma_f32_32x32x2f32(av[i], w2[i], acc2, 0, 0, 0); }
        }
        LAS float* rw = red + wave_ * (3 * 9 * 64) + lane_;
#pragma unroll
        for (int j = 0; j < 9; ++j) { rw[(0 * 9 + j) * 64] = acc0[j]; rw[(1 * 9 + j) * 64] = acc1[j]; rw[(2 * 9 + j) * 64] = acc2[j]; }
        __syncthreads();
        for (int o = tid_; o < 3 * 9 * 64; o += NTHREADS) { const int l = o & 63, j = (o >> 6) % 9, blk = (o >> 6) / 9; const int row = (j & 3) + 8 * (j >> 2) + 4 * (l >> 5), c2 = blk * 32 + (l & 31);
            if (row < 17) { float sacc = F.in[5][(size_t)li * 6144 + j0 + c2];
#pragma unroll
                for (int q = 0; q < 8; ++q) sacc += red[q * (3 * 9 * 64) + o];
                WSP(float, WS_MOD)[((size_t)li * 17 + row) * 6144 + j0 + c2] = sacc; } }
        __syncthreads();
    }
}

__device__ __forceinline__ void row_norm(f32x4 (&v)[4], float eps, int lane) {
    float s = 0.f;
#pragma unroll
    for (int j = 0; j < 4; ++j) s += (v[j][0] + v[j][1]) + (v[j][2] + v[j][3]);
    const float mean = wave_sum(s, lane) * (1.f / 1024.f); float q = 0.f;
#pragma unroll
    for (int j = 0; j < 4; ++j) { v[j] = v[j] - mean; q += (v[j][0] * v[j][0] + v[j][1] * v[j][1]) + (v[j][2] * v[j][2] + v[j][3] * v[j][3]); }
    const float rstd = __builtin_amdgcn_rsqf(wave_sum(q, lane) * (1.f / 1024.f) + eps);
#pragma unroll
    for (int j = 0; j < 4; ++j) v[j] = v[j] * rstd;
}
__device__ __forceinline__ int mod_row_of(int row) { return row < NCTX ? 16 : ((row - NCTX) >> 11); }
__device__ __forceinline__ void modulate_row(f32x4 (&v)[4], const float* modrow, int so, int lane) {
    row_norm(v, 1e-6f, lane);
#pragma unroll
    for (int j = 0; j < 4; ++j) { const f32x4 sh = *(const f32x4*)(modrow + so + lane * 4 + 256 * j), sc = *(const f32x4*)(modrow + so + 1024 + lane * 4 + 256 * j); v[j] = v[j] * (sc + 1.0f) + sh; }
}
__device__ __forceinline__ void store_row_bf16(bf16_t* p, const f32x4 (&v)[4], int lane) {
#pragma unroll
    for (int j = 0; j < 4; ++j) { u32x2 w; w.x = cvt_pk_bf16(v[j][0], v[j][1]); w.y = cvt_pk_bf16(v[j][2], v[j][3]); *(u32x2*)(p + lane * 4 + 256 * j) = w; }
}
__device__ __forceinline__ void dt_rows(const f32x4 (&hA)[4], const f32x4 (&hB)[4], const LAS float* wdt, float* dtA, float* dtB, int lane) {
    float part[32];
#pragma unroll
    for (int c = 0; c < 16; ++c) { f32x4 a = {0.f, 0.f, 0.f, 0.f}, b = a;
#pragma unroll
        for (int j = 0; j < 4; ++j) { const f32x4 w = *(const LAS f32x4*)(wdt + c * 1024 + lane * 4 + 256 * j); a += hA[j] * w; b += hB[j] * w; }
        part[c] = (a[0] + a[1]) + (a[2] + a[3]); part[16 + c] = (b[0] + b[1]) + (b[2] + b[3]); if ((c & 3) == 3) __builtin_amdgcn_sched_barrier(0); }
    const float v = bfly_reduce<32>(part, lane);
    const int idx = lane >> 1;
    if ((lane & 1) == 0) { if (idx < 16) dtA[idx] = v; else dtB[idx - 16] = v; }
}
__device__ __forceinline__ void p1_rows(Frame& F) {
    int tid_ = threadIdx.x; LAUNDER_V(tid_); const int lane_ = tid_ & 63, wave_ = __builtin_amdgcn_readfirstlane(tid_ >> 6); (void)lane_; (void)wave_;
    __syncthreads();
    LAS float* wdt = (LAS float*)F.lds;
    for (int i = tid_; i < 16 * 1024 / 4; i += NTHREADS) ((LAS f32x4*)wdt)[i] = ((const f32x4*)WSP(float, WS_WDT))[i];
    __syncthreads();
    const int gw = F.bid * NWAVES + wave_, NGW = F.G * NWAVES, lane = lane_;
    const float* mod = WSP(float, WS_MOD);
    for (int rp = gw; rp < NTOK / 2; rp += NGW) {
        const int rA = rp * 2, rB = rA + 1;
        const float* srcA = rA < NCTX ? F.in[2] + (size_t)rA * 1024 : F.in[0] + (size_t)(rA - NCTX) * 1024;
        const float* srcB = rB < NCTX ? F.in[2] + (size_t)rB * 1024 : F.in[0] + (size_t)(rB - NCTX) * 1024;
        f32x4 a[4], b[4];
#pragma unroll
        for (int j = 0; j < 4; ++j) { a[j] = ((const f32x4*)srcA)[lane + 64 * j]; b[j] = ((const f32x4*)srcB)[lane + 64 * j]; }
#pragma unroll
        for (int j = 0; j < 4; ++j) { ((f32x4*)(WSP(float, WS_XL) + (size_t)rA * 1024))[lane + 64 * j] = a[j]; ((f32x4*)(WSP(float, WS_XL) + (size_t)rB * 1024))[lane + 64 * j] = b[j]; }
        modulate_row(a, mod + (size_t)mod_row_of(rA) * 6144, 0, lane);
        modulate_row(b, mod + (size_t)mod_row_of(rB) * 6144, 0, lane);
        store_row_bf16(WSP(bf16_t, WS_H) + (size_t)rA * 1024, a, lane); store_row_bf16(WSP(bf16_t, WS_H) + (size_t)rB * 1024, b, lane);
        dt_rows(a, b, wdt, WSP(float, WS_DT) + (size_t)rA * 16, WSP(float, WS_DT) + (size_t)rB * 16, lane);
    }
}
__device__ __forceinline__ void p2b_rows(Frame& F, int li, int row_lo) {
    int tid_ = threadIdx.x; LAUNDER_V(tid_); const int lane_ = tid_ & 63, wave_ = __builtin_amdgcn_readfirstlane(tid_ >> 6); (void)lane_; (void)wave_;
    LAUNDER_S(li);
    const int gw = F.bid * NWAVES + wave_, NGW = F.G * NWAVES, lane = lane_;
    const bf16_t* proj = WSP(bf16_t, WS_PROJ); bf16_t* ys = WSP(bf16_t, WS_YS);
    const float* nw = F.in[24] + (size_t)li * 512 + lane * 8;
    const f32x4 nw0 = *(const f32x4*)nw, nw1 = *(const f32x4*)(nw + 4);
    const f32x4 pb0 = *(const f32x4*)(F.in[17] + (size_t)li * 512 + lane * 8), pb1 = *(const f32x4*)(F.in[17] + (size_t)li * 512 + lane * 8 + 4);
    const f32x4 ps0 = *(const f32x4*)(F.in[18] + (size_t)li * 512 + lane * 8), ps1 = *(const f32x4*)(F.in[18] + (size_t)li * 512 + lane * 8 + 4);
    const int pwin = 2 << (lane >> 4);
    for (int row = row_lo + gw; row < NTOK; row += NGW) {
        const size_t o5 = (size_t)row * 512 + lane * 8;
        const u32x4 hfv = *(const u32x4*)(WSP(bf16_t, WS_HF) + o5), hbv = *(const u32x4*)(WSP(bf16_t, WS_HB) + o5), yfv = *(const u32x4*)(WSP(bf16_t, WS_YF) + o5), ybv = *(const u32x4*)(WSP(bf16_t, WS_YB) + o5);
        const u32x4 rgv = *(const u32x4*)(proj + (size_t)row * PW + C_RG + lane * 8), zv = *(const u32x4*)(proj + (size_t)row * PW + C_Z + lane * 8);
        {
            const int L = row < NCTX ? CTXL : SEQ, segbase = row < NCTX ? (row & ~(CTXL - 1)) : NCTX + ((row - NCTX) & ~(SEQ - 1)), t = row - segbase;
            int lo = t - pwin / 2; lo = lo < 0 ? 0 : lo; int hi = t + pwin - 1 - pwin / 2; hi = hi > L - 1 ? L - 1 : hi;
            f32x4 s0 = {0.f, 0.f, 0.f, 0.f}, s1 = s0;
            u32x4 pv[16];
#pragma unroll
            for (int j = 0; j < 16; ++j) { int tj = t - 8 + j; tj = tj < 0 ? 0 : (tj > L - 1 ? L - 1 : tj); pv[j] = *(const u32x4*)(proj + (size_t)(segbase + tj) * PW + C_PU + lane * 8); }
            asm volatile("" ::: "memory");
#pragma unroll
            for (int j = 0; j < 16; ++j) { const int tj = t - 8 + j; const float mk = (tj >= lo && tj <= hi) ? 1.0f : 0.0f; const u32x4 v = pv[j];
                s0[0] += mk * lo_bf(v.x); s0[1] += mk * hi_bf(v.x); s0[2] += mk * lo_bf(v.y); s0[3] += mk * hi_bf(v.y); s1[0] += mk * lo_bf(v.z); s1[1] += mk * hi_bf(v.z); s1[2] += mk * lo_bf(v.w); s1[3] += mk * hi_bf(v.w); }
            const u32x4 sv = *(const u32x4*)(proj + (size_t)row * PW + C_PU + lane * 8);
            const float rc = __builtin_amdgcn_rcpf((float)(hi - lo + 1));
            f32x4 m0, m1; m0[0] = s0[0] * rc - lo_bf(sv.x); m0[1] = s0[1] * rc - hi_bf(sv.x); m0[2] = s0[2] * rc - lo_bf(sv.y); m0[3] = s0[3] * rc - hi_bf(sv.y);
            m1[0] = s1[0] * rc - lo_bf(sv.z); m1[1] = s1[1] * rc - hi_bf(sv.z); m1[2] = s1[2] * rc - lo_bf(sv.w); m1[3] = s1[3] * rc - hi_bf(sv.w);
            m0 = (m0 + pb0) * ps0; m1 = (m1 + pb1) * ps1;
            u32x4 w; w.x = cvt_pk_bf16(m0[0], m0[1]); w.y = cvt_pk_bf16(m0[2], m0[3]); w.z = cvt_pk_bf16(m1[0], m1[1]); w.w = cvt_pk_bf16(m1[2], m1[3]);
            *(u32x4*)(ys + (size_t)row * 2048 + 512 + lane * 8) = w;
        }
        {
            const f32x4 y0 = bf4lo_(hfv) + bf4lo_(hbv), y1 = bf4hi_(hfv) + bf4hi_(hbv);
            const f32x4 o0 = gelu4_(bf4lo_(rgv)) * y0, o1 = gelu4_(bf4hi_(rgv)) * y1;
            u32x4 w; w.x = cvt_pk_bf16(o0[0], o0[1]); w.y = cvt_pk_bf16(o0[2], o0[3]); w.z = cvt_pk_bf16(o1[0], o1[1]); w.w = cvt_pk_bf16(o1[2], o1[3]);
            *(u32x4*)(ys + (size_t)row * 2048 + lane * 8) = w;
        }
        {
            f32x4 g0 = (bf4lo_(yfv) + bf4lo_(ybv)) * silu4_(bf4lo_(zv)), g1 = (bf4hi_(yfv) + bf4hi_(ybv)) * silu4_(bf4hi_(zv));
            float ss = (g0[0] * g0[0] + g0[1] * g0[1]) + (g0[2] * g0[2] + g0[3] * g0[3]) + (g1[0] * g1[0] + g1[1] * g1[1]) + (g1[2] * g1[2] + g1[3] * g1[3]);
#pragma unroll
            for (int o = 1; o < 32; o <<= 1) ss += shx(ss, o, lane);
            const float r = __builtin_amdgcn_rsqf(ss * (1.f / 256.f) + 1e-5f);
            g0 = g0 * r * nw0; g1 = g1 * r * nw1;
            u32x4 w; w.x = cvt_pk_bf16(g0[0], g0[1]); w.y = cvt_pk_bf16(g0[2], g0[3]); w.z = cvt_pk_bf16(g1[0], g1[1]); w.w = cvt_pk_bf16(g1[2], g1[3]);
            *(u32x4*)(ys + (size_t)row * 2048 + 1536 + lane * 8) = w;
        }
    }
}
__device__ __forceinline__ void p5_rows(Frame& F, int li, int row_lo, bool dry) {
    int tid_ = threadIdx.x; LAUNDER_V(tid_); const int lane_ = tid_ & 63, wave_ = __builtin_amdgcn_readfirstlane(tid_ >> 6); (void)lane_; (void)wave_;
    LAUNDER_S(li);
    __syncthreads();
    LAS float* rw = (LAS float*)F.lds;
    LAS unsigned* hist = (LAS unsigned*)(F.lds + XTRA_OFF);
    LAS unsigned* basev = hist + 32;
    LAS unsigned* ent = hist + 64;
#pragma unroll 16
    for (int i = tid_; i < 32 * 1024 / 4; i += NTHREADS) ((LAS f32x4*)rw)[i] = ((const f32x4*)(WSP(float, WS_ROUT) + (size_t)li * 32 * 1024))[i];
    if (tid_ < 32) hist[tid_] = 0u;
    const int lane = lane_;
    const int nrows = NTOK - row_lo, per = (nrows / 2 + F.G - 1) / F.G;
    const int p_lo = F.bid * per, p_hi = (p_lo + per) < (nrows / 2) ? (p_lo + per) : (nrows / 2);
    const float* mod = WSP(float, WS_MOD) + (size_t)li * 17 * 6144;
    const float rb = F.in[32][li * 32 + (lane & 31)];
    unsigned* ecnt = WSP(unsigned, WS_CTL) + CW_ECNT + li * 32 * 64;
    LAS float* lgs = (LAS float*)(F.lds + XTRA_OFF + 4864);
    LAS float* mds = (LAS float*)(F.lds + XTRA2_OFF);
    const int mA = mod_row_of(row_lo + p_lo * 2) > 16 ? 16 : mod_row_of(row_lo + p_lo * 2), mB = mod_row_of(row_lo + (p_hi > p_lo ? p_hi * 2 - 1 : p_lo * 2)) > 16 ? 16 : mod_row_of(row_lo + (p_hi > p_lo ? p_hi * 2 - 1 : p_lo * 2));
    {   const int q = tid_ & 255; const float* src = (tid_ >> 8) ? F.in[28] + (size_t)li * 1024 : F.in[27] + (size_t)li * 1024;
        ((LAS f32x4*)lgs)[tid_] = ((const f32x4*)src)[q];
#pragma unroll
        for (int i = 0; i < 2; ++i) { const int idx = tid_ + 512 * i, sl = idx >> 9, q9 = idx & 511;
            ((LAS f32x4*)mds)[idx] = ((const f32x4*)(mod + (size_t)(sl ? mB : mA) * 6144 + 3072))[q9]; } }
    __syncthreads();
    const float* xl = WSP(float, WS_XL); const bf16_t* yb = WSP(bf16_t, WS_MACC);
    f32x4 ca[4], cb[4], na[4], nb[4]; u32x2 cya[4], cyb[4], nya[4], nyb[4];
#define P5_ISSUE(A_, B_, YA_, YB_, RP_) do { const int rA_ = row_lo + (RP_) * 2; _Pragma("unroll") for (int j = 0; j < 4; ++j) { A_[j] = ((const f32x4*)(xl + (size_t)rA_ * 1024))[lane + 64 * j]; B_[j] = ((const f32x4*)(xl + (size_t)(rA_ + 1) * 1024))[lane + 64 * j]; } \
        _Pragma("unroll") for (int j = 0; j < 4; ++j) { YA_[j] = *(const u32x2*)(yb + (size_t)rA_ * 1024 + lane * 4 + 256 * j); YB_[j] = *(const u32x2*)(yb + (size_t)(rA_ + 1) * 1024 + lane * 4 + 256 * j); } } while (0)
    int rp = p_lo + wave_;
    if (rp < p_hi) P5_ISSUE(ca, cb, cya, cyb, rp);
    for (; rp < p_hi; rp += NWAVES) {
        const int rA = row_lo + rp * 2, rB = rA + 1;
        float* xAo = (dry ? WSP(float, WS_HF) : WSP(float, WS_XL)) + (size_t)rA * 1024; float* xBo = (dry ? WSP(float, WS_HF) : WSP(float, WS_XL)) + (size_t)rB * 1024;
        bf16_t* hO = dry ? WSP(bf16_t, WS_XG) : WSP(bf16_t, WS_H);
        { const int rn = rp + NWAVES; const int rq = rn < p_hi ? rn : rp; P5_ISSUE(na, nb, nya, nyb, rq); }
        asm volatile("" ::: "memory");
        const LAS float* ms = mds + ((mod_row_of(rA) == mA) ? 0 : 2048);
        f32x4 a[4], b[4];
#pragma unroll
        for (int j = 0; j < 4; ++j) {
            const u32x2 ya = cya[j], yb2 = cyb[j];
            a[j] = ca[j] * DN_ALPHA + (f32x4){lo_bf(ya.x), hi_bf(ya.x), lo_bf(ya.y), hi_bf(ya.y)}; b[j] = cb[j] * DN_ALPHA + (f32x4){lo_bf(yb2.x), hi_bf(yb2.x), lo_bf(yb2.y), hi_bf(yb2.y)}; }
        row_norm(a, 1e-5f, lane); row_norm(b, 1e-5f, lane);
#pragma unroll
        for (int j = 0; j < 4; ++j) { const f32x4 g = *(const LAS f32x4*)(lgs + lane * 4 + 256 * j), bb = *(const LAS f32x4*)(lgs + 1024 + lane * 4 + 256 * j); a[j] = a[j] * g + bb; b[j] = b[j] * g + bb;
            ((f32x4*)xAo)[lane + 64 * j] = a[j]; ((f32x4*)xBo)[lane + 64 * j] = b[j]; }
        row_norm(a, 1e-6f, lane); row_norm(b, 1e-6f, lane);
#pragma unroll
        for (int j = 0; j < 4; ++j) { const f32x4 sh = *(const LAS f32x4*)(ms + lane * 4 + 256 * j), sc = *(const LAS f32x4*)(ms + 1024 + lane * 4 + 256 * j); a[j] = a[j] * (sc + 1.0f) + sh; b[j] = b[j] * (sc + 1.0f) + sh; }
        store_row_bf16(hO + (size_t)rA * 1024, a, lane); store_row_bf16(hO + (size_t)rB * 1024, b, lane);
#pragma unroll
        for (int j = 0; j < 4; ++j) { ca[j] = na[j]; cb[j] = nb[j]; cya[j] = nya[j]; cyb[j] = nyb[j]; }
        float res[2];
#pragma unroll
        for (int hf = 0; hf < 2; ++hf) {
            float part[32];
#pragma unroll
            for (int e = 0; e < 16; ++e) { f32x4 sa = {0.f, 0.f, 0.f, 0.f}, sb = sa;
#pragma unroll
                for (int j = 0; j < 4; ++j) { const f32x4 w = *(const LAS f32x4*)(rw + (hf * 16 + e) * 1024 + lane * 4 + 256 * j); sa += a[j] * w; sb += b[j] * w; }
                part[e] = (sa[0] + sa[1]) + (sa[2] + sa[3]); part[16 + e] = (sb[0] + sb[1]) + (sb[2] + sb[3]); if ((e & 3) == 3) __builtin_amdgcn_sched_barrier(0); }
            res[hf] = bfly_reduce<32>(part, lane);
            __builtin_amdgcn_sched_barrier(0);
        }
        const int srcl = (lane & 32) | ((lane & 15) << 1);
        const float r0 = shl_(res[0], srcl), r1 = shl_(res[1], srcl);
        float lv = ((lane & 16) ? r1 : r0) + rb;
        float selv[4]; int sele[4];
#pragma unroll
        for (int k = 0; k < 4; ++k) {
            float m = lv; int mi = lane & 31;
#pragma unroll
            for (int o = 16; o >= 1; o >>= 1) { const float om = shx(m, o, lane); const int oi = shxi(mi, o, lane); if (om > m || (om == m && oi < mi)) { m = om; mi = oi; } }
            selv[k] = m; sele[k] = mi; if ((lane & 31) == mi) lv = -INFINITY;
        }
        const float e1 = __expf(selv[1] - selv[0]), e2 = __expf(selv[2] - selv[0]), e3 = __expf(selv[3] - selv[0]); const float inv = __builtin_amdgcn_rcpf(1.0f + e1 + e2 + e3);
        const int k = lane & 31;
        if (k < 4) {
            const int row = (lane >> 5) ? rB : rA;
            const float pk = (k == 0 ? 1.0f : k == 1 ? e1 : k == 2 ? e2 : e3) * inv; const int ek = (k == 0 ? sele[0] : k == 1 ? sele[1] : k == 2 ? sele[2] : sele[3]);
            if (!dry) WSP(float, WS_EP)[(size_t)row * 4 + k] = pk;
            const unsigned lp = __hip_atomic_fetch_add(&hist[ek], 1u, __ATOMIC_RELAXED, __HIP_MEMORY_SCOPE_WORKGROUP);
            const int n = ((rp - p_lo) * 2 + (lane >> 5)) * 4 + k;
            ent[n * 2] = (unsigned)(row * 4 + k); ent[n * 2 + 1] = (unsigned)ek | (lp << 8);
        }
    }
    __syncthreads();
    if (dry) return;
    if (tid_ < 32) basev[tid_] = atomicAdd(&ecnt[tid_ * 64], hist[tid_]);
    __syncthreads();
    const int nent = (p_hi > p_lo ? (p_hi - p_lo) : 0) * 8;
    int* elist = WSP(int, WS_ELIST);
    for (int n = tid_; n < nent; n += NTHREADS) { const unsigned t4 = ent[n * 2], w = ent[n * 2 + 1]; const unsigned e = w & 255u, lp = w >> 8; elist[(size_t)e * ECAP + basev[e] + lp] = (int)t4; }
}
__device__ __forceinline__ void moe_tstart(Frame& F, int li, LAS int* tstart) {
    __syncthreads();
    int tid = threadIdx.x; LAUNDER_V(tid); LAUNDER_S(li);
    if (tid < 32) {
        const unsigned* ecnt = WSP(unsigned, WS_CTL) + CW_ECNT + li * 32 * 64;
        const int lane = tid;
        const int nt = ((int)__hip_atomic_load(ecnt + lane * 64, __ATOMIC_RELAXED, __HIP_MEMORY_SCOPE_AGENT) + 255) >> 8;
        int incl = nt;
#pragma unroll
        for (int o = 1; o < 32; o <<= 1) { const int t = __builtin_amdgcn_ds_bpermute(((lane - o) & 63) << 2, incl); incl += (lane >= o) ? t : 0; }
        tstart[lane] = incl - nt;
        if (lane == 31) tstart[32] = incl;
    }
    __syncthreads();
}
__device__ __forceinline__ void moe_toks(Frame& F, int li, const LAS int* tstart, LAS unsigned short* toks, int nN) {
    const unsigned* ecnt = WSP(unsigned, WS_CTL) + CW_ECNT + li * 32 * 64; const int* elist = WSP(int, WS_ELIST);
    int tid = threadIdx.x; LAUNDER_V(tid); LAUNDER_S(li);
    const int total = tstart[32];
    int tk[14]; int nu = 0;
#pragma unroll
    for (int j = 0; j < 14; ++j) {
        const int i = (tid >> 8) + 2 * j; int mtg, pn; tk[j] = 0;
        if (moe_unit(i, F.bid, F.G, nN, total, mtg, pn)) {
            int e = 0;
            for (int k = 1; k < 32; ++k) e += (tstart[k] <= mtg) ? 1 : 0;
            const int pos = (mtg - tstart[e]) * 256 + (tid & 255);
            const int cnt = ((tstart[e + 1] - tstart[e] - 1) == (mtg - tstart[e])) ? (int)ecnt[e * 64] : 0x7fffffff;
            tk[j] = elist[(size_t)e * ECAP + (pos < cnt ? pos : 0)] | (pos < cnt ? 0 : (int)0x80000000);
            nu = j + 1;
        }
    }
#pragma unroll
    for (int j = 0; j < 14; ++j) if (j < nu) { const int i = (tid >> 8) + 2 * j; toks[i * 256 + (tid & 255)] = (unsigned short)(tk[j] < 0 ? 0 : (tk[j] >> 2)); }
    __syncthreads();
}
struct P9Ld { unsigned yw[2][4][4]; f32x4 xv[2][4]; f32x4 pkv[2]; };
__device__ __forceinline__ void p9_issue(P9Ld& L, const unsigned char* y2, const float* xl, const float* ep, int rp, int lane) {
#pragma unroll
    for (int h = 0; h < 2; ++h) { const int row = rp * 2 + h; L.pkv[h] = *(const f32x4*)(ep + (size_t)row * 4);
#pragma unroll
        for (int j = 0; j < 4; ++j) { L.xv[h][j] = ((const f32x4*)(xl + (size_t)row * 1024))[lane + 64 * j];
#pragma unroll
            for (int k = 0; k < 4; ++k) L.yw[h][j][k] = *(const unsigned*)(y2 + ((size_t)row * 4 + k) * 1024 + lane * 4 + 256 * j); } }
}
__device__ __forceinline__ void p9_rows(Frame& F, int li, int row_lo, bool dry) {
    int tid_ = threadIdx.x; LAUNDER_V(tid_); const int lane_ = tid_ & 63, wave_ = __builtin_amdgcn_readfirstlane(tid_ >> 6); (void)lane_; (void)wave_;
    LAUNDER_S(li);
    __syncthreads();
    const bool lastl = (li == DEPTH - 1);
    LAS float* wdt = (LAS float*)F.lds;
    LAS float* lgs = (LAS float*)(F.lds + 65536);
    LAS float* mds = (LAS float*)(F.lds + 65536 + 8192);
    const int nrows = NTOK - row_lo, per = (nrows / 2 + F.G - 1) / F.G;
    const int p_lo = row_lo / 2 + F.bid * per, p_hi = (p_lo + per) < (NTOK / 2) ? (p_lo + per) : (NTOK / 2);
    const int mA = mod_row_of(p_lo * 2), mB = mod_row_of(p_hi > p_lo ? p_hi * 2 - 1 : p_lo * 2);
    const float* mod = WSP(float, WS_MOD) + (size_t)li * 17 * 6144;
    const float* modn = WSP(float, WS_MOD) + (size_t)(lastl ? li : li + 1) * 17 * 6144;
    if (!lastl) {
#pragma unroll 8
        for (int i = tid_; i < 16 * 1024 / 4; i += NTHREADS) ((LAS f32x4*)wdt)[i] = ((const f32x4*)(WSP(float, WS_WDT) + (size_t)(li + 1) * 16 * 1024))[i]; }
    {   const int q = tid_ & 255; const float* src = (tid_ >> 8) ? F.in[30] + (size_t)li * 1024 : F.in[29] + (size_t)li * 1024;
        ((LAS f32x4*)lgs)[tid_] = ((const f32x4*)src)[q];
#pragma unroll
        for (int i = 0; i < 3; ++i) { const int idx = tid_ + 512 * i, sl = idx / 768, c = (idx % 768) >> 8, q4 = idx & 255; const int mr = sl ? mB : mA;
            const float* sp = (c == 0) ? mod + (size_t)mr * 6144 + 5120 : modn + (size_t)mr * 6144 + (c - 1) * 1024;
            ((LAS f32x4*)mds)[idx] = ((const f32x4*)sp)[q4]; } }
    __syncthreads();
    const int lane = lane_;
    const unsigned char* y2 = WSP(unsigned char, WS_Y2);
    const float* xl = WSP(float, WS_XL); const float* ep = WSP(float, WS_EP);
    P9Ld cur, nxt;
    int rp = p_lo + wave_;
    if (rp < p_hi) p9_issue(cur, y2, xl, ep, rp, lane);
    for (; rp < p_hi; rp += NWAVES) {
        { const int rn = rp + NWAVES; p9_issue(nxt, y2, xl, ep, rn < p_hi ? rn : rp, lane); }
        asm volatile("" ::: "memory");
        const LAS float* ms = mds + ((mod_row_of(rp * 2) == mA) ? 0 : 3 * 1024);
        f32x4 v[2][4];
#pragma unroll
        for (int h = 0; h < 2; ++h) {
#pragma unroll
            for (int j = 0; j < 4; ++j) { f32x4 f = {0.f, 0.f, 0.f, 0.f};
#pragma unroll
                for (int k = 0; k < 4; ++k) { const int w = (int)cur.yw[h][j][k]; const float pk = cur.pkv[h][k]; const f32x2 lo2 = __builtin_amdgcn_cvt_pk_f32_fp8(w, false), hi2 = __builtin_amdgcn_cvt_pk_f32_fp8(w, true);
                    f += (f32x4){lo2[0], lo2[1], hi2[0], hi2[1]} * pk; }
                const f32x4 g = *(const LAS f32x4*)(ms + lane * 4 + 256 * j);
                v[h][j] = cur.xv[h][j] * DN_ALPHA + g * f; } }
#pragma unroll
        for (int h = 0; h < 2; ++h) {
            const int row = rp * 2 + h;
            float* xw = (dry ? WSP(float, WS_HF) : WSP(float, WS_XL)) + (size_t)row * 1024;
            row_norm(v[h], 1e-5f, lane);
#pragma unroll
            for (int j = 0; j < 4; ++j) { const f32x4 g = *(const LAS f32x4*)(lgs + lane * 4 + 256 * j), bb = *(const LAS f32x4*)(lgs + 1024 + lane * 4 + 256 * j); v[h][j] = v[h][j] * g + bb; }
            if (lastl) {
#pragma unroll
                for (int j = 0; j < 4; ++j) ((f32x4*)((dry ? WSP(float, WS_HF) : F.out) + (size_t)(row - NCTX) * 1024))[lane + 64 * j] = v[h][j];
            } else {
#pragma unroll
                for (int j = 0; j < 4; ++j) ((f32x4*)xw)[lane + 64 * j] = v[h][j];
                row_norm(v[h], 1e-6f, lane);
#pragma unroll
                for (int j = 0; j < 4; ++j) { const f32x4 sh = *(const LAS f32x4*)(ms + 1024 + lane * 4 + 256 * j), sc = *(const LAS f32x4*)(ms + 2048 + lane * 4 + 256 * j); v[h][j] = v[h][j] * (sc + 1.0f) + sh; }
                store_row_bf16((dry ? WSP(bf16_t, WS_XG) : WSP(bf16_t, WS_H)) + (size_t)row * 1024, v[h], lane);
            }
        }
        if (!lastl) { float* dto = dry ? WSP(float, WS_YF) : WSP(float, WS_DT); dt_rows(v[0], v[1], wdt, dto + (size_t)(rp * 2) * 16, dto + (size_t)(rp * 2 + 1) * 16, lane); }
        cur = nxt;
    }
}

__device__ __forceinline__ void ssd_unit2(Frame& F, int li, int b, int hp, int dir, bool ctx_out) {
    constexpr int P72 = 72;
    constexpr int RP = 264;
    LAS bf16_t* RAW = (LAS bf16_t*)F.lds;
    LAS bf16_t* BN = (LAS bf16_t*)(F.lds + 35968);
    LAS bf16_t* CN = BN + 64 * P72;
    LAS bf16_t* BT = CN + 64 * P72;
    LAS bf16_t* XT = BT + 64 * P72;
    LAS bf16_t* XDT = XT + 2 * 64 * P72;
    LAS bf16_t* HS = XDT + 2 * 64 * P72;
    LAS float* CUM = (LAS float*)(HS + 2 * 64 * P72);
    LAS float* DTS = CUM + 128; LAS float* RDT = DTS + 128; LAS float* ED = RDT + 128; LAS float* TOT = ED + 128;
    LAS float* CW = TOT + 8;
    int tid = threadIdx.x; LAUNDER_V(tid); LAUNDER_S(li);
    const int lane = tid & 63, w = __builtin_amdgcn_readfirstlane(tid >> 6), r32 = lane & 31, hh = lane >> 5;
    const int hsel = w >> 2, pt = (w >> 1) & 1, lt = w & 1, g = hp >> 1;
    const int hd = hp * 2 + hsel;
    const bf16_t* proj = WSP(bf16_t, WS_PROJ); const float* dtp = WSP(float, WS_DT);
    bf16_t* yd = dir ? WSP(bf16_t, WS_YB) : WSP(bf16_t, WS_YF);
    __syncthreads();
    for (int i = tid; i < 5 * 256; i += NTHREADS) { const int k = i >> 8, ch = i & 255; const int gc = ch < 128 ? hp * 128 + ch : (ch < 192 ? 512 + g * 64 + (ch - 128) : 640 + g * 64 + (ch - 192));
        CW[i] = k < 4 ? F.in[19][((size_t)li * 4 + k) * 768 + gc] : F.in[20][(size_t)li * 768 + gc]; }
    for (int i = tid; i < 2 * 64 * P72 / 2; i += NTHREADS) ((LAS unsigned*)HS)[i] = 0u;
    const float av = -__expf(F.in[22][(li * 2 + dir) * 8 + hd]) * 1.4426950408889634f, dtb = F.in[21][(li * 2 + dir) * 8 + hd], dsk = F.in[23][(li * 2 + dir) * 8 + hd];
    const int g8 = tid & 31;
    const int rcol = g8 < 16 ? C_XBC + hp * 128 + g8 * 8 : (g8 < 24 ? C_XBC + 512 + g * 64 + (g8 - 16) * 8 : C_XBC + 640 + g * 64 + (g8 - 24) * 8);
    f32x16 Hreg = (f32x16){};
    u32x4 pre[5]; float predt = 0.f;
    auto chunk_pos = [&](int c, int& L, int& rowbase, int& t0) { const int seg = c >= 4, ci = seg ? c - 4 : c; L = seg ? SEQ : CTXL; rowbase = seg ? NCTX + b * SEQ : b * CTXL; const int nch = L / 64; t0 = (dir ? nch - 1 - ci : ci) * 64; };
    auto prefetch = [&](int c) {
        int L, rowbase, t0; chunk_pos(c, L, rowbase, t0);
#pragma unroll
        for (int i = 0; i < 5; ++i) { const int idx = tid + 512 * i; const int r = idx >> 5; int tr = t0 - 2 + r; tr = tr < 0 ? 0 : (tr > L - 1 ? L - 1 : tr);
            pre[i] = *(const u32x4*)(proj + (size_t)(rowbase + tr) * PW + rcol); }
        if ((w & 3) == 0) predt = dtp[(size_t)(rowbase + t0 + lane) * 16 + dir * 8 + hd];
    };
    prefetch(0);
#pragma unroll 1
    for (int c = 0; c < 36; ++c) {
        int L, rowbase, t0; chunk_pos(c, L, rowbase, t0);
#pragma unroll
        for (int i = 0; i < 5; ++i) { const int idx = tid + 512 * i; const int r = idx >> 5, tr = t0 - 2 + r; u32x4 v = pre[i]; if (tr < 0 || tr >= L) v = (u32x4){0u, 0u, 0u, 0u};
            if (idx < 68 * 32) *(LAS u32x4*)(RAW + r * RP + g8 * 8) = v; }
        if ((w & 3) == 0) {
            const float dt = softplusf_(predt + dtb); const float a = dt * av;
            float cs = a;
#pragma unroll
            for (int o = 1; o < 64; o <<= 1) { const int src = dir ? lane + o : lane - o; const float t = shl_(cs, src & 63); const bool ok = dir ? (lane + o < 64) : (lane >= o); cs += ok ? t : 0.f; }
            const float cend = shl_(cs, dir ? 0 : 63);
            CUM[hsel * 64 + lane] = cs; DTS[hsel * 64 + lane] = dt; RDT[hsel * 64 + lane] = 1.0f / dt; ED[hsel * 64 + lane] = exp2f(cend - cs);
            if (lane == 0) TOT[hsel] = exp2f(cend);
        }
        {
            LAS bf16_t* hq = HS + hsel * 64 * P72 + 32 * lt + r32;
#pragma unroll
            for (int r = 0; r < 16; ++r) hq[(32 * pt + (r & 3) + 8 * (r >> 2) + 4 * hh) * P72] = f2bf(Hreg[r]);
        }
        LDS_BARRIER();
        if (c + 1 < 36) prefetch(c + 1);
#pragma unroll
        for (int i = 0; i < 4; ++i) {
            const int tt = lane, gs = w + 8 * i;
            f32x4 a0 = *(const LAS f32x4*)(CW + 4 * 256 + gs * 8), a1 = *(const LAS f32x4*)(CW + 4 * 256 + gs * 8 + 4);
#pragma unroll
            for (int k = 0; k < 4; ++k) { const u32x4 rv = *(const LAS u32x4*)(RAW + (tt + k) * RP + gs * 8); const f32x4 w0 = *(const LAS f32x4*)(CW + k * 256 + gs * 8), w1 = *(const LAS f32x4*)(CW + k * 256 + gs * 8 + 4);
                a0[0] += w0[0] * lo_bf(rv.x); a0[1] += w0[1] * hi_bf(rv.x); a0[2] += w0[2] * lo_bf(rv.y); a0[3] += w0[3] * hi_bf(rv.y);
                a1[0] += w1[0] * lo_bf(rv.z); a1[1] += w1[1] * hi_bf(rv.z); a1[2] += w1[2] * lo_bf(rv.w); a1[3] += w1[3] * hi_bf(rv.w); }
            float u[8];
            { const f32x4 u0 = silu4_(a0), u1 = silu4_(a1);
#pragma unroll
              for (int j = 0; j < 4; ++j) { u[j] = u0[j]; u[4 + j] = u1[j]; } }
            if (gs < 16) {
                const int hs2 = gs >> 3; const float dtv = DTS[hs2 * 64 + tt], edv = ED[hs2 * 64 + tt];
                LAS bf16_t* xp = XT + (hs2 * 64 + (gs & 7) * 8) * P72 + tt; LAS bf16_t* xdp = XDT + (hs2 * 64 + (gs & 7) * 8) * P72 + tt;
#pragma unroll
                for (int j = 0; j < 8; ++j) { const float x = u[j] * dtv; xp[j * P72] = f2bf(x); xdp[j * P72] = f2bf(x * edv); }
            } else {
                u32x4 pk; pk.x = cvt_pk_bf16(u[0], u[1]); pk.y = cvt_pk_bf16(u[2], u[3]); pk.z = cvt_pk_bf16(u[4], u[5]); pk.w = cvt_pk_bf16(u[6], u[7]);
                if (gs < 24) { const int n0 = (gs - 16) * 8; *(LAS u32x4*)(BN + tt * P72 + n0) = pk;
#pragma unroll
                    for (int j = 0; j < 8; ++j) BT[(n0 + j) * P72 + tt] = f2bf(u[j]);
                } else { const int n0 = (gs - 24) * 8; *(LAS u32x4*)(CN + tt * P72 + n0) = pk; }
            }
        }
        LDS_BARRIER();
        {
            const int l = 32 * lt + r32;
            const float cl = CUM[hsel * 64 + l];
            bf16x8 cfr[4];
#pragma unroll
            for (int ks = 0; ks < 4; ++ks) cfr[ks] = *(const LAS bf16x8*)(CN + l * P72 + 16 * ks + 8 * hh);
            f32x16 acc2 = (f32x16){};
#pragma unroll
            for (int ks = 0; ks < 4; ++ks) { const bf16x8 hf = *(const LAS bf16x8*)(HS + (hsel * 64 + 32 * pt + r32) * P72 + 16 * ks + 8 * hh); acc2 = __builtin_amdgcn_mfma_f32_32x32x16_bf16(hf, cfr[ks], acc2, 0, 0, 0); }
            f32x16 acc1 = (f32x16){};
#pragma unroll
            for (int st = 0; st < 2; ++st) {
                const bool need = dir ? (st >= lt) : (st <= lt);
                if (need) {
                    f32x16 gt = (f32x16){};
#pragma unroll
                    for (int ks = 0; ks < 4; ++ks) { const bf16x8 bf = *(const LAS bf16x8*)(BN + (32 * st + r32) * P72 + 16 * ks + 8 * hh); gt = __builtin_amdgcn_mfma_f32_32x32x16_bf16(bf, cfr[ks], gt, 0, 0, 0); }
                    const float diag = dsk * RDT[hsel * 64 + l];
#pragma unroll
                    for (int r4 = 0; r4 < 4; ++r4) { const f32x4 csv = *(const LAS f32x4*)(CUM + hsel * 64 + 32 * st + 8 * r4 + 4 * hh);
#pragma unroll
                        for (int q = 0; q < 4; ++q) { const int sidx = 32 * st + 8 * r4 + 4 * hh + q; const float d = fminf(cl - csv[q], 0.f); const bool valid = dir ? (sidx >= l) : (sidx <= l);
                            float wv = valid ? gt[4 * r4 + q] * __builtin_amdgcn_exp2f(d) : 0.f; if (sidx == l) wv += diag; gt[4 * r4 + q] = wv; } }
#pragma unroll
                    for (int k2 = 0; k2 < 2; ++k2) {
                        u32x4 pw; pw.x = cvt_pk_bf16(gt[8 * k2 + 0], gt[8 * k2 + 1]); pw.y = cvt_pk_bf16(gt[8 * k2 + 2], gt[8 * k2 + 3]); pw.z = cvt_pk_bf16(gt[8 * k2 + 4], gt[8 * k2 + 5]); pw.w = cvt_pk_bf16(gt[8 * k2 + 6], gt[8 * k2 + 7]);
                        const LAS bf16_t* xq = XT + (hsel * 64 + 32 * pt + r32) * P72 + 32 * st + 16 * k2 + 4 * hh;
                        const u32x2 x0 = *(const LAS u32x2*)xq, x1 = *(const LAS u32x2*)(xq + 8);
                        const u32x4 xa = {x0.x, x0.y, x1.x, x1.y};
                        acc1 = __builtin_amdgcn_mfma_f32_32x32x16_bf16(__builtin_bit_cast(bf16x8, xa), __builtin_bit_cast(bf16x8, pw), acc1, 0, 0, 0);
                    }
                }
            }
            const float ecl = __builtin_amdgcn_exp2f(cl);
            if (c >= 4 || ctx_out) {
                bf16_t* yrow = yd + (size_t)(rowbase + t0 + l) * 512 + hd * 64 + 32 * pt + 4 * hh;
#pragma unroll
                for (int r4 = 0; r4 < 4; ++r4) { f32x4 o;
#pragma unroll
                    for (int q = 0; q < 4; ++q) o[q] = acc1[4 * r4 + q] + ecl * acc2[4 * r4 + q];
                    u32x2 ow; ow.x = cvt_pk_bf16(o[0], o[1]); ow.y = cvt_pk_bf16(o[2], o[3]); *(u32x2*)(yrow + 8 * r4) = ow; }
            }
            f32x16 acc3 = (f32x16){};
#pragma unroll
            for (int ks = 0; ks < 4; ++ks) { const bf16x8 xf = *(const LAS bf16x8*)(XDT + (hsel * 64 + 32 * pt + r32) * P72 + 16 * ks + 8 * hh); const bf16x8 bf = *(const LAS bf16x8*)(BT + (32 * lt + r32) * P72 + 16 * ks + 8 * hh);
                acc3 = __builtin_amdgcn_mfma_f32_32x32x16_bf16(xf, bf, acc3, 0, 0, 0); }
            const float tot = TOT[hsel];
#pragma unroll
            for (int r = 0; r < 16; ++r) Hreg[r] = tot * Hreg[r] + acc3[r];
        }
        LDS_BARRIER();
    }
}
__device__ __forceinline__ void rglru_unit(Frame& F, int li, int b, int blk, int dir, bool ctx_out) {
    LAS bf16_t* raw = (LAS bf16_t*)F.lds;
    constexpr int FP = 68;
    LAS float* u_s = (LAS float*)(F.lds + 8704);
    LAS bf16_t* ub_s = (LAS bf16_t*)(F.lds + 8704 + 17408);
    LAS float* a_s = (LAS float*)(F.lds + 8704 + 17408 + 9216);
    LAS float* b_s = a_s + 64 * FP; LAS float* h_s = b_s + 64 * FP; LAS float* sg_s = h_s + 64 * FP;
    int tid = threadIdx.x; LAUNDER_V(tid); LAUNDER_S(li);
    const int lane = tid & 63, w = __builtin_amdgcn_readfirstlane(tid >> 6), mt = w & 3, ntp = w >> 2;
    const bf16_t* proj = WSP(bf16_t, WS_PROJ);
    bf16_t* hd_ = dir ? WSP(bf16_t, WS_HB) : WSP(bf16_t, WS_HF);
    __syncthreads();
    f32x4 cwr[5][2];
#pragma unroll
    for (int k = 0; k < 5; ++k) { const float* cp = k < 4 ? F.in[7] + ((size_t)li * 4 + k) * 512 + blk * 64 + (tid & 7) * 8 : F.in[8] + (size_t)li * 512 + blk * 64 + (tid & 7) * 8; cwr[k][0] = *(const f32x4*)cp; cwr[k][1] = *(const f32x4*)(cp + 4); }
    bf16x8 Wf[2][2][2];
    f32x4 ba4[2], bx4[2], nl4[2];
#pragma unroll
    for (int ntl = 0; ntl < 2; ++ntl) {
        const int nt = ntp * 2 + ntl;
#pragma unroll
        for (int gate = 0; gate < 2; ++gate)
#pragma unroll
            for (int ks = 0; ks < 2; ++ks)
                Wf[gate][ntl][ks] = *(const bf16x8*)(WSP(bf16_t, WS_RNNW) + ((((size_t)(li * 2 + dir) * 2 + gate) * 8 + blk) * 64 + 16 * nt + (lane & 15)) * 64 + 32 * ks + 8 * (lane >> 4));
        const int ch = blk * 64 + 16 * nt + 4 * (lane >> 4);
        ba4[ntl] = *(const f32x4*)(F.in[10] + (size_t)(li * 2 + dir) * 512 + ch); bx4[ntl] = *(const f32x4*)(F.in[12] + (size_t)(li * 2 + dir) * 512 + ch);
        const f32x4 lm = *(const f32x4*)(F.in[13] + (size_t)(li * 2 + dir) * 512 + ch);
#pragma unroll
        for (int r = 0; r < 4; ++r) nl4[ntl][r] = -8.0f * softplusf_(-lm[r]);
    }
    float h = 0.f;
    u32x4 pre[2];
    auto chunk_pos = [&](int c, int& L, int& rowbase, int& t0) { const int seg = c >= 4, ci = seg ? c - 4 : c; L = seg ? SEQ : CTXL; rowbase = seg ? NCTX + b * SEQ : b * CTXL; const int nch = L / 64; t0 = (dir ? nch - 1 - ci : ci) * 64; };
    auto prefetch = [&](int c) { int L, rowbase, t0; chunk_pos(c, L, rowbase, t0);
#pragma unroll
        for (int i = 0; i < 2; ++i) { const int idx = tid + 512 * i; int tr = t0 - 2 + (idx >> 3); tr = tr < 0 ? 0 : (tr > L - 1 ? L - 1 : tr);
            pre[i] = *(const u32x4*)(proj + (size_t)(rowbase + tr) * PW + C_RX + blk * 64 + (idx & 7) * 8); } };
    prefetch(0);
    {
#pragma unroll 1
        for (int c = 0; c < 36; ++c) {
            int L, rowbase, t0; chunk_pos(c, L, rowbase, t0); const int seg = c >= 4;
            LDS_BARRIER();
#pragma unroll
            for (int i = 0; i < 2; ++i) { const int idx = tid + 512 * i; const int r = idx >> 3, tr = t0 - 2 + r; u32x4 v = pre[i]; if (tr < 0 || tr >= L) v = (u32x4){0u, 0u, 0u, 0u};
                if (idx < 67 * 8) *(LAS u32x4*)(raw + r * 64 + (idx & 7) * 8) = v; }
            LDS_BARRIER();
            if (c + 1 < 36) prefetch(c + 1);
            {   const int tt = tid >> 3, c8 = tid & 7;
                f32x4 a0 = cwr[4][0], a1 = cwr[4][1];
#pragma unroll
                for (int k = 0; k < 4; ++k) { const u32x4 rv = *(const LAS u32x4*)(raw + (tt + k) * 64 + c8 * 8);
                    a0[0] += cwr[k][0][0] * lo_bf(rv.x); a0[1] += cwr[k][0][1] * hi_bf(rv.x); a0[2] += cwr[k][0][2] * lo_bf(rv.y); a0[3] += cwr[k][0][3] * hi_bf(rv.y);
                    a1[0] += cwr[k][1][0] * lo_bf(rv.z); a1[1] += cwr[k][1][1] * hi_bf(rv.z); a1[2] += cwr[k][1][2] * lo_bf(rv.w); a1[3] += cwr[k][1][3] * hi_bf(rv.w); }
                *(LAS f32x4*)(u_s + tt * FP + c8 * 8) = a0; *(LAS f32x4*)(u_s + tt * FP + c8 * 8 + 4) = a1;
                u32x4 pk; pk.x = cvt_pk_bf16(a0[0], a0[1]); pk.y = cvt_pk_bf16(a0[2], a0[3]); pk.z = cvt_pk_bf16(a1[0], a1[1]); pk.w = cvt_pk_bf16(a1[2], a1[3]);
                *(LAS u32x4*)(ub_s + tt * 72 + c8 * 8) = pk; }
            LDS_BARRIER();
            {
                const bf16x8 uf0 = *(const LAS bf16x8*)(ub_s + (16 * mt + (lane & 15)) * 72 + 8 * (lane >> 4)), uf1 = *(const LAS bf16x8*)(ub_s + (16 * mt + (lane & 15)) * 72 + 32 + 8 * (lane >> 4));
                const int tt = 16 * mt + (lane & 15);
#pragma unroll
                for (int ntl = 0; ntl < 2; ++ntl) {
                    f32x4 aR = {0.f, 0.f, 0.f, 0.f}, aI = aR;
                    aR = __builtin_amdgcn_mfma_f32_16x16x32_bf16(Wf[0][ntl][0], uf0, aR, 0, 0, 0); aR = __builtin_amdgcn_mfma_f32_16x16x32_bf16(Wf[0][ntl][1], uf1, aR, 0, 0, 0);
                    aI = __builtin_amdgcn_mfma_f32_16x16x32_bf16(Wf[1][ntl][0], uf0, aI, 0, 0, 0); aI = __builtin_amdgcn_mfma_f32_16x16x32_bf16(Wf[1][ntl][1], uf1, aI, 0, 0, 0);
                    const int j0 = 16 * (ntp * 2 + ntl) + 4 * (lane >> 4);
                    const f32x4 uu = *(const LAS f32x4*)(u_s + tt * FP + j0);
                    f32x4 av, bv;
                    {
                        const f32x4 rr = sig4_((aR + ba4[ntl]) * -1.4426950408889634f), ig = sig4_((aI + bx4[ntl]) * -1.4426950408889634f);
                        const f32x4 la = rr * nl4[ntl], x2 = la * 2.0f, le = la * 1.4426950408889634f;
                        const f32x4 pol = (x2 * -1.0f) * ((x2 * 0.5f) * (x2 * 0.33333333f + 1.0f) + 1.0f);
#pragma unroll
                        for (int r = 0; r < 4; ++r) av[r] = __builtin_amdgcn_exp2f(le[r]);
                        const f32x4 oma = av * av * -1.0f + 1.0f;
                        f32x4 sq;
#pragma unroll
                        for (int r = 0; r < 4; ++r) sq[r] = __builtin_amdgcn_sqrtf(x2[r] > -0.02f ? pol[r] : oma[r]);
                        bv = sq * ig * uu; }
                    *(LAS f32x4*)(a_s + tt * FP + j0) = av; *(LAS f32x4*)(b_s + tt * FP + j0) = bv;
                }
            }
            LDS_BARRIER();
            {
                float av[8], bv[8];
#pragma unroll
                for (int j = 0; j < 8; ++j) { const int sidx = 8 * w + j, tt = dir ? 63 - sidx : sidx; av[j] = a_s[tt * FP + lane]; bv[j] = b_s[tt * FP + lane]; }
                float P = 1.f, Hl = 0.f;
#pragma unroll
                for (int j = 0; j < 8; ++j) { P *= av[j]; Hl = av[j] * Hl + bv[j]; }
                sg_s[w * 64 + lane] = P; sg_s[512 + w * 64 + lane] = Hl;
                LDS_BARRIER();
                float cin = h, cc = h;
#pragma unroll
                for (int j = 0; j < 8; ++j) { if (j == w) cin = cc; cc = sg_s[j * 64 + lane] * cc + sg_s[512 + j * 64 + lane]; }
                h = cc;
#pragma unroll
                for (int j = 0; j < 8; ++j) { cin = av[j] * cin + bv[j]; const int sidx = 8 * w + j, tt = dir ? 63 - sidx : sidx; h_s[tt * FP + lane] = cin; }
            }
            LDS_BARRIER();
            if (seg || ctx_out) for (int i = tid; i < 64 * 16; i += NTHREADS) { const int tt = i >> 4, q4 = i & 15;
                const f32x4 hv = *(const LAS f32x4*)(h_s + tt * FP + q4 * 4); u32x2 hw; hw.x = cvt_pk_bf16(hv[0], hv[1]); hw.y = cvt_pk_bf16(hv[2], hv[3]);
                *(u32x2*)(hd_ + (size_t)(rowbase + t0 + tt) * 512 + blk * 64 + q4 * 4) = hw; }
        }
    }
}
typedef short v4i16_t __attribute__((ext_vector_type(4)));
__device__ __forceinline__ void glds16(const void* gsrc, unsigned lds_dst) { unsigned keep;
    asm volatile("s_mov_b32 %0, m0\n\ts_mov_b32 m0, %2\n\ts_nop 0\n\tglobal_load_lds_dwordx4 %1, off\n\ts_mov_b32 m0, %0" : "=&s"(keep) : "v"(gsrc), "s"(lds_dst) : "memory"); }
__device__ __forceinline__ void attn_unit(Frame& F, int li, int b, int h, int qt) {
    constexpr int KB = 64 * 64 * 2, VB = 64 * 128 * 2, BUF = KB + VB, NBUF = 4;
    int tid = threadIdx.x; LAUNDER_V(tid); LAUNDER_S(li);
    const int lane = tid & 63, w = __builtin_amdgcn_readfirstlane(tid >> 6), r32 = lane & 31, hh = lane >> 5;
    const bool isctx = (qt == 8);
    const int qrow0 = isctx ? b * CTXL : NCTX + b * SEQ + qt * 256;
    const int ntiles = isctx ? 4 : 36;
    const bf16_t* proj = WSP(bf16_t, WS_PROJ);
    float lam;
    { const float* lv = F.in[14] + (size_t)li * 256; const float s1 = wave_sum(lv[lane] * lv[64 + lane], lane), s2 = wave_sum(lv[128 + lane] * lv[192 + lane], lane); const float lam_init = 0.8f - 0.6f * __expf(-0.3f * (float)li); lam = __expf(s1) - __expf(s2) + lam_init; }
    const float lam_init = 0.8f - 0.6f * __expf(-0.3f * (float)li);
    f32x4* o0p = WSP(f32x4, WS_ATT) + ((size_t)F.bid * 512 + tid) * 16;
    const int vtr_base = ((lane >> 4) & 1) * 32 + (lane & 3) * 8 + (4 * hh + ((lane & 15) >> 2)) * 64;
    const unsigned lds0 = (unsigned)(uintptr_t)F.lds;
    const int dk_key = 8 * w + (lane >> 3), dk_col = ((lane & 7) ^ (dk_key & 7)) * 8;
    int dv_key[2], dv_col[2];
#pragma unroll
    for (int j = 0; j < 2; ++j) { const int sidx = 2 * (2 * w + j) + (lane >> 5); dv_key[j] = 8 * (sidx >> 2) + ((lane & 31) >> 2); dv_col[j] = 32 * (sidx & 3) + (lane & 3) * 8; }
    int koff[4];
#pragma unroll
    for (int ks = 0; ks < 4; ++ks) koff[ks] = ((2 * ks + hh) ^ (r32 & 7)) * 16;
#pragma unroll 1
    for (int c = 0; c < 2; ++c) {
        float m_run = 0.f;
        f32x16 o[4]; float lsum = 0.f;
        const bf16x8 ones = (bf16x8){0x3f80, 0x3f80, 0x3f80, 0x3f80, 0x3f80, 0x3f80, 0x3f80, 0x3f80};
#pragma unroll
        for (int et = 0; et < 4; ++et) o[et] = (f32x16){};
        auto dma = [&](int t) {
            const int krow = (t < 4) ? (b * CTXL + t * 64) : (NCTX + b * SEQ + (t - 4) * 64);
            const unsigned base = (unsigned)__builtin_amdgcn_readfirstlane((int)(lds0 + (unsigned)((t & (NBUF - 1)) * BUF + w * 1024)));
            glds16(proj + (size_t)(krow + dk_key) * PW + C_K + h * 128 + c * 64 + dk_col, base);
#pragma unroll
            for (int j = 0; j < 2; ++j) glds16(proj + (size_t)(krow + dv_key[j]) * PW + C_V + h * 128 + dv_col[j], base + (unsigned)(KB + w * 1024 + j * 1024));
        };
        __syncthreads();
        dma(0); dma(1); dma(2); dma(3);
        bf16x8 qf[4];
        { const bf16_t* qp = proj + (size_t)(qrow0 + 32 * w + r32) * PW + C_Q + h * 128 + c * 64 + 8 * hh;
#pragma unroll
          for (int ks = 0; ks < 4; ++ks) qf[ks] = *(const bf16x8*)(qp + 16 * ks); }
        asm volatile("s_waitcnt vmcnt(0)" : "+v"(qf[0]), "+v"(qf[1]), "+v"(qf[2]), "+v"(qf[3]) :: "memory");
        __syncthreads();
#pragma unroll 1
        for (int t = 0; t < ntiles; ++t) {
            const int bsel = t & (NBUF - 1);
            LAS unsigned char* kfp = F.lds + bsel * BUF + r32 * 128; LAS unsigned char* vfp = F.lds + bsel * BUF + KB + vtr_base;
            asm volatile("" : "+v"(kfp)); asm volatile("" : "+v"(vfp));
            f32x16 S[2];
            {   f32x16 negm;
#pragma unroll
                for (int r = 0; r < 16; ++r) negm[r] = -m_run;
                bf16x8 kf0[4], kf1[4];
#pragma unroll
                for (int ks = 0; ks < 4; ++ks) kf0[ks] = *(const LAS bf16x8*)(kfp + koff[ks]);
                __builtin_amdgcn_sched_barrier(0);
#pragma unroll
                for (int ks = 0; ks < 4; ++ks) kf1[ks] = *(const LAS bf16x8*)(kfp + koff[ks] + 4096);
                S[0] = negm;
#pragma unroll
                for (int ks = 0; ks < 4; ++ks) S[0] = __builtin_amdgcn_mfma_f32_32x32x16_bf16(kf0[ks], qf[ks], S[0], 0, 0, 0);
                __builtin_amdgcn_sched_barrier(0);
                S[1] = negm;
#pragma unroll
                for (int ks = 0; ks < 4; ++ks) S[1] = __builtin_amdgcn_mfma_f32_32x32x16_bf16(kf1[ks], qf[ks], S[1], 0, 0, 0); }
            float mx = fmaxf(S[0][0], S[1][0]);
#pragma unroll
            for (int r = 1; r < 16; ++r) mx = fmaxf(fmaxf(mx, S[0][r]), S[1][r]);
            mx = fmaxf(mx, shx(mx, 32, lane));
            if (t == 0 || __any(mx > 8.0f)) {
                const float dl = (t == 0) ? mx : fmaxf(mx, 0.f), alpha = (t == 0) ? 1.0f : __builtin_amdgcn_exp2f(-dl);
                m_run += dl;
#pragma unroll
                for (int kt = 0; kt < 2; ++kt)
#pragma unroll
                    for (int r = 0; r < 16; ++r) S[kt][r] -= dl;
#pragma unroll
                for (int et = 0; et < 4; ++et) o[et] = o[et] * alpha;
                lsum *= alpha;
            }
#pragma unroll
            for (int kt = 0; kt < 2; ++kt)
#pragma unroll
                for (int r = 0; r < 16; ++r) S[kt][r] = __builtin_amdgcn_exp2f(S[kt][r]);
            {   f32x2 rs = {0.f, 0.f};
#pragma unroll
                for (int kt = 0; kt < 2; ++kt)
#pragma unroll
                    for (int r = 0; r < 16; r += 2) rs += (f32x2){S[kt][r], S[kt][r + 1]};
                lsum += rs[0] + rs[1]; }
            bf16x8 pf[2][2];
#pragma unroll
            for (int kt = 0; kt < 2; ++kt)
#pragma unroll
                for (int s2 = 0; s2 < 2; ++s2) { u32x4 pw; pw.x = cvt_pk_bf16(S[kt][8 * s2 + 0], S[kt][8 * s2 + 1]); pw.y = cvt_pk_bf16(S[kt][8 * s2 + 2], S[kt][8 * s2 + 3]);
                    pw.z = cvt_pk_bf16(S[kt][8 * s2 + 4], S[kt][8 * s2 + 5]); pw.w = cvt_pk_bf16(S[kt][8 * s2 + 6], S[kt][8 * s2 + 7]); pf[kt][s2] = __builtin_bit_cast(bf16x8, pw); }
            {
                s16x4 va[2][4][2];
#define ATT_VLOAD(buf, et_) _Pragma("unroll") for (int kk = 0; kk < 4; ++kk) { LAS unsigned char* vp = vfp + ((2 * kk) * 4 + (et_)) * 512; \
                    va[buf][kk][0] = __builtin_bit_cast(s16x4, __builtin_amdgcn_ds_read_tr16_b64_v4i16((LAS v4i16_t*)vp)); va[buf][kk][1] = __builtin_bit_cast(s16x4, __builtin_amdgcn_ds_read_tr16_b64_v4i16((LAS v4i16_t*)(vp + 2048))); }
#define ATT_VMMA(buf, et_) __builtin_amdgcn_s_setprio(1); _Pragma("unroll") for (int kk = 0; kk < 4; ++kk) { const s16x4 lo = va[buf][kk][0], hi = va[buf][kk][1]; const bf16x8 vf = (bf16x8){lo[0], lo[1], lo[2], lo[3], hi[0], hi[1], hi[2], hi[3]}; \
                    o[et_] = __builtin_amdgcn_mfma_f32_32x32x16_bf16(vf, pf[kk >> 1][kk & 1], o[et_], 0, 0, 0); } __builtin_amdgcn_s_setprio(0);
#define ATT_SB __builtin_amdgcn_sched_barrier(0);
                ATT_VLOAD(0, 0) ATT_SB ATT_VLOAD(1, 1) ATT_SB
                ATT_VMMA(0, 0) ATT_SB ATT_VLOAD(0, 2) ATT_SB
                ATT_VMMA(1, 1) ATT_SB ATT_VLOAD(1, 3) ATT_SB
                ATT_VMMA(0, 2) ATT_SB
                ATT_VMMA(1, 3)
#undef ATT_SB
#undef ATT_VLOAD
#undef ATT_VMMA
            }
            if (t + 3 < ntiles) asm volatile("s_waitcnt vmcnt(6)" ::: "memory"); else if (t + 2 < ntiles) asm volatile("s_waitcnt vmcnt(3)" ::: "memory"); else asm volatile("s_waitcnt vmcnt(0)" ::: "memory");
            LDS_BARRIER();
            if (t + 4 < ntiles) dma(t + 4);
        }
        const float inv = __builtin_amdgcn_rcpf(lsum + shx(lsum, 32, lane));
        if (c == 0) {
#pragma unroll
            for (int et = 0; et < 4; ++et)
#pragma unroll
                for (int r4 = 0; r4 < 4; ++r4) o0p[et * 4 + r4] = (f32x4){o[et][4 * r4] * inv, o[et][4 * r4 + 1] * inv, o[et][4 * r4 + 2] * inv, o[et][4 * r4 + 3] * inv};
        } else {
            float ss = 0.f;
            const float li2 = lam * inv;
#pragma unroll
            for (int et = 0; et < 4; ++et) {
#pragma unroll
                for (int r4 = 0; r4 < 4; ++r4) { const f32x4 p0 = o0p[et * 4 + r4];
#pragma unroll
                    for (int q = 0; q < 4; ++q) { const float v = p0[q] - li2 * o[et][4 * r4 + q]; o[et][4 * r4 + q] = v; ss += v * v; } }
            }
            ss += shx(ss, 32, lane);
            const float rn = __builtin_amdgcn_rsqf(ss * (1.f / 128.f) + 1e-5f) * (1.0f - lam_init);
            LAS bf16_t* st = (LAS bf16_t*)(F.lds + w * (32 * 136 * 2));
#pragma unroll
            for (int et = 0; et < 4; ++et)
#pragma unroll
                for (int r = 0; r < 16; ++r) { const int e = 32 * et + (r & 3) + 8 * (r >> 2) + 4 * hh; st[r32 * 136 + e] = f2bf(o[et][r] * rn); }
            LDS_WAIT(); asm volatile("" ::: "memory");
            const float* sw = F.in[15] + (size_t)li * 128 + (lane & 15) * 8;
            const f32x4 sw0 = *(const f32x4*)sw, sw1 = *(const f32x4*)(sw + 4);
#pragma unroll
            for (int i = 0; i < 8; ++i) { const int idx = i * 64 + lane, q = idx >> 4, ch = idx & 15;
                const u32x4 v = *(const LAS u32x4*)(st + q * 136 + ch * 8);
                u32x4 ov; ov.x = cvt_pk_bf16(lo_bf(v.x) * sw0[0], hi_bf(v.x) * sw0[1]); ov.y = cvt_pk_bf16(lo_bf(v.y) * sw0[2], hi_bf(v.y) * sw0[3]);
                ov.z = cvt_pk_bf16(lo_bf(v.z) * sw1[0], hi_bf(v.z) * sw1[1]); ov.w = cvt_pk_bf16(lo_bf(v.w) * sw1[2], hi_bf(v.w) * sw1[3]);
                *(u32x4*)(WSP(bf16_t, WS_YS) + (size_t)(qrow0 + 32 * w + q) * 2048 + 1024 + h * 128 + ch * 8) = ov; }
        }
    }
}
__device__ __forceinline__ void p2_mixers(Frame& F, int li, int rep) {
    const bool need_ctx = (li < DEPTH - 1);
    const int n3 = need_ctx ? 960 : 896;
    volatile LAS int* qslot = (volatile LAS int*)(F.lds + MISC_OFF + 64);
    unsigned* qhead = WSP(unsigned, WS_CTL) + CW_QHEAD + (li * 2 + rep) * 64;
    for (;;) {
        __syncthreads();
        if (threadIdx.x == 0) *qslot = (int)__hip_atomic_fetch_add(qhead, 1u, __ATOMIC_RELAXED, __HIP_MEMORY_SCOPE_AGENT);
        __syncthreads();
        const int u = *qslot;
        if (u >= n3) break;
#ifndef TESTUNIT
#define TESTUNIT 15
#endif
#ifndef REPUNIT
#define REPUNIT 0
#endif
#define UREP(j) _Pragma("unroll 1") for (int urep_ = 0; urep_ < (((REPUNIT >> (j)) & 1) ? 2 : 1); ++urep_)
        if (u < 128) { if (TESTUNIT & 1) UREP(0) ssd_unit2(F, li, u >> 3, (u >> 1) & 3, u & 1, need_ctx); }
        else if (u < 640) { const int v = u - 128; if (TESTUNIT & 4) UREP(2) attn_unit(F, li, v >> 5, (v >> 3) & 3, v & 7); }
        else if (u < 896) { const int v = u - 640; if (TESTUNIT & 2) UREP(1) rglru_unit(F, li, v >> 4, (v >> 1) & 7, v & 1, need_ctx); }
        else { const int q = u - 896; if (TESTUNIT & 4) UREP(3) attn_unit(F, li, q >> 2, q & 3, 8); }
    }
}

__device__ __forceinline__ bool in_range_(int lo, int hi, int k) { asm volatile("" : "+s"(k)); return lo <= k && k < hi; }
struct Args { const float* in[37]; float* out; unsigned char* ws; int ph_lo, ph_hi; };
constexpr int NPH = 2 + DEPTH * 9;
__global__ void __launch_bounds__(NTHREADS, 2) fwd_kernel(Args args) {
    extern __shared__ __attribute__((aligned(16))) unsigned char lds_raw[];
    Frame F;
    F.lds = (LAS unsigned char*)lds_raw;
    F.G = gridDim.x; F.bid = blockIdx.x;
    F.in = args.in;
    F.out = args.out; F.ws = args.ws;
    volatile LAS unsigned* MISC = (volatile LAS unsigned*)(F.lds + MISC_OFF);
    if (threadIdx.x < 4) MISC[threadIdx.x] = 0u;
    __syncthreads();
    const int lo = args.ph_lo, hi = args.ph_hi;
    XcdBarrier bar; bar.bar = WSP(unsigned, WS_CTL) + CW_BAR; bar.x = 0; bar.st = nullptr;
    if (hi - lo > 1) bar = xcd_barrier_post(WSP(unsigned, WS_CTL) + CW_BAR, MISC);
#ifdef TESTPH
#define PH_EN(k) (((k) < 2 ? (k) : 2 + ((k) - 2) % 9) == TESTPH)
#else
#define PH_EN(k) true
#endif
#define IN(k) (PH_EN(k) && in_range_(lo, hi, (k)))
#ifndef BARX
#define BARX 0
#endif
#define SEAM(k) do { if (in_range_(lo, hi - 1, (k))) { xcd_barrier(bar); if (BARX) xcd_barrier(bar); } } while (0)
#ifndef REPMASK
#define REPMASK 0
#endif
#define NREP(j) (((REPMASK >> (j)) & 1) ? 2 : 1)
#define REPEAT(j) _Pragma("unroll 1") for (int rep_ = 0; rep_ < NREP(j); ++rep_)

#ifndef P0SEL
#define P0SEL 3
#endif
    if (IN(0)) { REPEAT(10) { if (rep_ == 0 || (P0SEL & 1)) p0_weights(F); if (rep_ == 0 || (P0SEL & 2)) p0_mod(F); } } SEAM(0);
    if (IN(1)) { REPEAT(11) { p1_rows(F); } } SEAM(1);
#pragma unroll 1
    for (int li = 0; li < DEPTH; ++li) {
        const int pb = 2 + li * 9;
        const bool need_ctx = (li < DEPTH - 1);
        const int pm0 = need_ctx ? 0 : 16;
        const int row_lo = pm0 * 256;
        if (IN(pb + 0)) REPEAT(0) {
            int li_ = li; LAUNDER_S(li_);
            SchedGrid S{NTOK / 256, PW / 256, F.G, F.bid, 0, (const char*)WSP(bf16_t, WS_H), (const char*)(WSP(bf16_t, WS_WIN) + (size_t)li_ * PW * 1024), (size_t)256 * 2048, (size_t)256 * 2048};
            EpiProj E{WSP(bf16_t, WS_PROJ), WSP(float, WS_ROPE), WSP(float, WS_ROPE) + 1024, WSP(unsigned char, WS_XG)};
            pg8::gemm_phase(F.lds, 1024, 2048u, 2048u, S, E);
        } SEAM(pb + 0);
        if (IN(pb + 1)) REPEAT(1) { p2_mixers(F, li, rep_); } SEAM(pb + 1);
        if (IN(pb + 2)) REPEAT(2) { p2b_rows(F, li, row_lo); } SEAM(pb + 2);
        if (IN(pb + 3)) REPEAT(3) {   int li_ = li; LAUNDER_S(li_);
            SchedQuad S{NTOK / 128 - 2 * pm0, 8, F.G, F.bid, 2 * pm0, (const char*)WSP(bf16_t, WS_YS), (const char*)(WSP(bf16_t, WS_WBR) + (size_t)li_ * 2 * 1024 * 1024)};
            EpiQuad E{WSP(unsigned char, WS_XG), WSP(bf16_t, WS_M)};
            pg8::gemm_phase<EpiQuad, SchedQuad, true>(F.lds, 1024, 4096u, 2048u, S, E);
        } SEAM(pb + 3);
        if (IN(pb + 4)) REPEAT(4) {
            int li_ = li; LAUNDER_S(li_); const bool dry = (NREP(4) == 2) && rep_ == 0;
            SchedGrid S{NTOK / 256 - pm0, 4, F.G, F.bid, pm0, (const char*)WSP(bf16_t, WS_M), (const char*)(WSP(bf16_t, WS_WOUT) + (size_t)li_ * 1024 * 1024), (size_t)256 * 2048, (size_t)256 * 2048};
            EpiOut E{WSP(bf16_t, WS_MACC), WSP(float, WS_MOD) + (size_t)li_ * 17 * 6144}; (void)dry;
            pg8::gemm_phase(F.lds, 1024, 2048u, 2048u, S, E);
        } SEAM(pb + 4);
        if (IN(pb + 5)) REPEAT(5) { p5_rows(F, li, row_lo, (NREP(5) == 2) && rep_ == 0); } SEAM(pb + 5);
        if (IN(pb + 6)) REPEAT(7) {
            int li_ = li; LAUNDER_S(li_);
            LAS int* tstart = (LAS int*)(F.lds + XTRA_OFF);
            LAS unsigned short* toks = (LAS unsigned short*)(F.lds + XTRA_OFF + 256);
            moe_tstart(F, li_, tstart);
            moe_toks(F, li_, tstart, toks, 8);
            SchedMoe S{tstart, toks, 8, F.G, F.bid, (const char*)WSP(bf16_t, WS_H), (const char*)(WSP(bf16_t, WS_WGU) + (size_t)li_ * 32 * 2048 * 1024), (size_t)0, (size_t)256 * 2048, (size_t)2048 * 2048};
            EpiGU E{WSP(bf16_t, WS_HID), F.in[34] + (size_t)li_ * 32 * 2048};
            pg8::gemm_phase(F.lds, 1024, 2048u, 2048u, S, E);
        } SEAM(pb + 6);
        if (IN(pb + 7)) REPEAT(8) {
            int li_ = li; LAUNDER_S(li_);
            LAS int* tstart = (LAS int*)(F.lds + XTRA_OFF);
            moe_tstart(F, li_, tstart);
            SchedMoe S{tstart, nullptr, 4, F.G, F.bid, (const char*)WSP(bf16_t, WS_HID), (const char*)(WSP(bf16_t, WS_WD) + (size_t)li_ * 32 * 1024 * 1024), (size_t)256 * 2048, (size_t)256 * 2048, (size_t)1024 * 2048};
            EpiDown E{WSP(unsigned char, WS_Y2), F.in[36] + (size_t)li_ * 32 * 1024, WSP(int, WS_ELIST), WSP(unsigned, WS_CTL) + CW_ECNT + li_ * 32 * 64};
            pg8::gemm_phase(F.lds, 1024, 2048u, 2048u, S, E);
        } SEAM(pb + 7);
        if (IN(pb + 8)) REPEAT(9) { p9_rows(F, li, row_lo, (NREP(9) == 2) && rep_ == 0); } SEAM(pb + 8);
    }
#undef IN
#undef SEAM
}

extern "C" void kernel_launch(void* const* d_in, const int* in_sizes, int n_in, void* d_out, int out_size, void* d_ws, size_t ws_size, hipStream_t stream) {
    static int grid = 0;
    if (grid == 0) {
        if (n_in != 37 || out_size != NLAT * D || ws_size < WS_END) { fprintf(stderr, "kernel_launch: unexpected shapes (n_in %d, out %d, ws %zu < %zu)\n", n_in, out_size, ws_size, (size_t)WS_END); grid = -1; return; }
        int dev = 0, cus = 0, per_cu = 0;
        if (hipGetDevice(&dev) != hipSuccess || hipDeviceGetAttribute(&cus, hipDeviceAttributeMultiprocessorCount, dev) != hipSuccess) { grid = -1; return; }
        if (hipFuncSetAttribute((const void*)fwd_kernel, hipFuncAttributeMaxDynamicSharedMemorySize, LDS_BYTES) != hipSuccess) { fprintf(stderr, "kernel_launch: hipFuncSetAttribute failed\n"); grid = -1; return; }
        if (hipOccupancyMaxActiveBlocksPerMultiprocessor(&per_cu, (const void*)fwd_kernel, NTHREADS, LDS_BYTES) != hipSuccess || per_cu < 1) { fprintf(stderr, "kernel_launch: occupancy query says %d\n", per_cu); }
        (void)hipGetLastError();
        grid = cus;
        if (grid != 256) fprintf(stderr, "kernel_launch: %d CUs (built for 256)\n", grid);
    }
    if (grid < 0) return;
    (void)hipMemsetAsync((char*)d_ws + WS_CTL, 0, CTL_BYTES, stream);
    Args a{};
    for (int i = 0; i < 37; ++i) a.in[i] = (const float*)d_in[i];
    a.out = (float*)d_out; a.ws = (unsigned char*)d_ws;
#if MK_N_LAUNCHES == 1
    a.ph_lo = 0; a.ph_hi = NPH;
    hipLaunchKernelGGL(fwd_kernel, dim3(grid), dim3(NTHREADS), LDS_BYTES, stream, a);
#else
    for (int p = 0; p < NPH; ++p) { a.ph_lo = p; a.ph_hi = p + 1; hipLaunchKernelGGL(fwd_kernel, dim3(grid), dim3(NTHREADS), LDS_BYTES, stream, a); }
#endif
    const hipError_t le = hipPeekAtLastError();
    if (le != hipSuccess) fprintf(stderr, "kernel_launch: launch failed: %s\n", hipGetErrorName(le));
}
```

```cpp
#include <hip/hip_runtime.h>
#include <cstdio>
#include <cstdint>

#ifndef MK_N_LAUNCHES
#define MK_N_LAUNCHES 1
#endif

#define GAS __attribute__((address_space(1)))
#define LAS __attribute__((address_space(3)))
typedef unsigned short bf16_t;
typedef short bf16x8 __attribute__((ext_vector_type(8)));
typedef short s16x4 __attribute__((ext_vector_type(4)));
typedef float f32x2 __attribute__((ext_vector_type(2)));
typedef float f32x4 __attribute__((ext_vector_type(4)));
typedef float f32x16 __attribute__((ext_vector_type(16)));
typedef unsigned u32x2 __attribute__((ext_vector_type(2)));
typedef unsigned u32x4 __attribute__((ext_vector_type(4)));

constexpr int D = 1024, NBATCH = 16, SEQ = 2048, CTXL = 256, DEPTH = 4;
constexpr int NCTX = NBATCH * CTXL;
constexpr int NLAT = NBATCH * SEQ;
constexpr int NTOK = NCTX + NLAT;
constexpr int PW = 8448;
constexpr int C_RX = 0, C_RG = 512, C_Q = 1024, C_K = 1536, C_V = 2048, C_PU = 2560, C_Z = 3072, C_XBC = 3584, C_MG = 4352;
constexpr int INW = 8464;
constexpr int NEXP = 32, ECAP = NTOK;
constexpr int NSLOT = NTOK * 4 + NEXP * 256;
constexpr float DN_ALPHA = 1.6817928305074290f;
constexpr int NWAVES = 8, NTHREADS = 512;
constexpr float QSCALE = 0.125f * 1.4426950408889634f;

constexpr size_t al256(size_t x) { return (x + 255) & ~(size_t)255; }
constexpr size_t WS_CTL = 0, CTL_BYTES = 1u << 20;
constexpr size_t WS_MOD = WS_CTL + CTL_BYTES;
constexpr size_t WS_ROPE = WS_MOD + al256((size_t)DEPTH * 17 * 6144 * 4);
constexpr size_t WS_WDT = WS_ROPE + 8192;
constexpr size_t WS_ROUT = WS_WDT + (size_t)DEPTH * 16 * 1024 * 4;
constexpr size_t WS_WIN = WS_ROUT + (size_t)DEPTH * 32 * 1024 * 4;
constexpr size_t WS_WGU = WS_WIN + (size_t)DEPTH * PW * 1024 * 2;
constexpr size_t WS_WD = WS_WGU + (size_t)DEPTH * 32 * 2048 * 1024 * 2;
constexpr size_t WS_WBR = WS_WD + (size_t)DEPTH * 32 * 1024 * 1024 * 2;
constexpr size_t WS_WOUT = WS_WBR + (size_t)DEPTH * 4 * 1024 * 512 * 2;
constexpr size_t WS_POOLW = WS_WOUT + (size_t)DEPTH * 1024 * 1024 * 2;
constexpr size_t WS_RNNW = WS_POOLW + (size_t)DEPTH * 4 * 128 * 128 * 2;
constexpr size_t WS_XL = WS_RNNW + (size_t)DEPTH * 2 * 2 * 8 * 64 * 64 * 2;
constexpr size_t WS_H = WS_XL + (size_t)NTOK * 1024 * 4;
constexpr size_t WS_PROJ = WS_H + (size_t)NTOK * 1024 * 2;
constexpr size_t WS_DT = WS_PROJ + (size_t)NTOK * PW * 2;
constexpr size_t WS_HF = WS_DT + (size_t)NTOK * 16 * 4;
constexpr size_t WS_HB = WS_HF + (size_t)NTOK * 512 * 4;
constexpr size_t WS_YF = WS_HB + (size_t)NTOK * 512 * 4;
constexpr size_t WS_YB = WS_YF + (size_t)NTOK * 512 * 4;
constexpr size_t WS_YS = WS_YB + (size_t)NTOK * 512 * 4;
constexpr size_t WS_MACC = WS_YS + (size_t)NTOK * 2048 * 2;
constexpr size_t WS_M = WS_MACC + (size_t)NTOK * 1024 * 4;
constexpr size_t WS_EP = WS_M + (size_t)NTOK * 1024 * 2;
constexpr size_t WS_ELIST = WS_EP + (size_t)NTOK * 4 * 4;
constexpr size_t WS_XG = WS_ELIST + (size_t)NEXP * ECAP * 4;
constexpr size_t WS_HID = WS_XG + (size_t)NSLOT * 1024 * 2;
constexpr size_t WS_Y2 = WS_HID + (size_t)NSLOT * 1024 * 2;
constexpr size_t WS_ATT = WS_Y2 + (size_t)NTOK * 4 * 1024 * 2;
constexpr size_t WS_END = WS_ATT + (size_t)256 * 16 * 512 * 16;
constexpr int CW_BAR = 4096;
constexpr int CW_ECNT = 16384;
constexpr int CW_QHEAD = 32768;

constexpr int SCR_BYTES = 131072;
constexpr int XTRA_OFF = SCR_BYTES;
constexpr int MISC_OFF = SCR_BYTES + 15872;
constexpr int XTRA2_OFF = 147456;
constexpr int LDS_BYTES = 163840;

__device__ __forceinline__ float bf2f(bf16_t b) { return __uint_as_float(((unsigned)b) << 16); }
__device__ __forceinline__ unsigned cvt_pk_bf16(float lo, float hi) { unsigned r; asm volatile("v_cvt_pk_bf16_f32 %0, %1, %2" : "=v"(r) : "v"(lo), "v"(hi)); return r; }
__device__ __forceinline__ bf16_t f2bf(float f) { return (bf16_t)(cvt_pk_bf16(f, 0.f) & 0xffffu); }
__device__ __forceinline__ float lo_bf(unsigned w) { return __uint_as_float(w << 16); }
__device__ __forceinline__ float hi_bf(unsigned w) { return __uint_as_float(w & 0xffff0000u); }
__device__ __forceinline__ float sigmoidf_(float x) { return __builtin_amdgcn_rcpf(1.0f + __builtin_amdgcn_exp2f(-1.4426950408889634f * x)); }
__device__ __forceinline__ float siluf_(float x) { return x * __builtin_amdgcn_rcpf(1.0f + __builtin_amdgcn_exp2f(-1.4426950408889634f * x)); }
__device__ __forceinline__ float softplusf_(float x) { const float e = __expf(x); return x > 20.f ? x : (e < 1e-4f ? e * (1.0f - 0.5f * e) : __logf(1.0f + e)); }
__device__ __forceinline__ float gelu_tanh(float x) { const float u = 0.7978845608028654f * (x + 0.044715f * x * x * x); const float e = __builtin_amdgcn_exp2f(2.8853900817779268f * u); const float t = 1.f - 2.f * __builtin_amdgcn_rcpf(e + 1.f); return 0.5f * x * (1.f + t); }
__device__ __forceinline__ f32x4 sig4_(f32x4 t) { f32x4 e; _Pragma("unroll") for (int j = 0; j < 4; ++j) e[j] = __builtin_amdgcn_exp2f(t[j]); e = e + 1.0f; f32x4 r; _Pragma("unroll") for (int j = 0; j < 4; ++j) r[j] = __builtin_amdgcn_rcpf(e[j]); return r; }
__device__ __forceinline__ f32x4 silu4_(f32x4 x) { return x * sig4_(x * -1.4426950408889634f); }
__device__ __forceinline__ f32x4 gelu4_(f32x4 x) { const f32x4 x2 = x * x; return x * sig4_(x * (x2 * (-2.0f * 0.7978845608028654f * 0.044715f * 1.4426950408889634f) + (-2.0f * 0.7978845608028654f * 1.4426950408889634f))); }
__device__ __forceinline__ f32x4 bf4lo_(u32x4 v) { return (f32x4){lo_bf(v.x), hi_bf(v.x), lo_bf(v.y), hi_bf(v.y)}; }
__device__ __forceinline__ f32x4 bf4hi_(u32x4 v) { return (f32x4){lo_bf(v.z), hi_bf(v.z), lo_bf(v.w), hi_bf(v.w)}; }
__device__ __forceinline__ int shxi(int v, int o, int lane) {
    if (__builtin_constant_p(o)) {
        if (o == 32) { const auto rr = __builtin_amdgcn_permlane32_swap((unsigned)v, (unsigned)v, false, false); return (lane & 32) ? (int)rr[0] : (int)rr[1]; }
        if (o == 16) { const auto rr = __builtin_amdgcn_permlane16_swap((unsigned)v, (unsigned)v, false, false); return (lane & 16) ? (int)rr[0] : (int)rr[1]; }
        if (o == 8) return __builtin_amdgcn_update_dpp(0, v, 0x140, 0xf, 0xf, true);
        if (o == 4) return __builtin_amdgcn_update_dpp(0, v, 0x141, 0xf, 0xf, true);
        if (o == 2) return __builtin_amdgcn_update_dpp(0, v, 0x4E, 0xf, 0xf, true);
        if (o == 1) return __builtin_amdgcn_update_dpp(0, v, 0xB1, 0xf, 0xf, true);
    }
    return __builtin_amdgcn_ds_bpermute((lane ^ o) << 2, v);
}
__device__ __forceinline__ float shx(float v, int o, int lane) { return __int_as_float(shxi(__float_as_int(v), o, lane)); }
__device__ __forceinline__ float shl_(float v, int src_lane) { return __int_as_float(__builtin_amdgcn_ds_bpermute(src_lane << 2, __float_as_int(v))); }
__device__ __forceinline__ float wave_sum(float v, int lane) {
#pragma unroll
    for (int o = 1; o < 64; o <<= 1) v += shx(v, o, lane);
    return v;
}
template <int H, int OFF, int NN> __device__ __forceinline__ void bfly_rec(float (&p)[NN], int lane) {
    if constexpr (H >= 1) {
        const bool up = (lane & OFF) != 0;
#pragma unroll
        for (int i = 0; i < H; ++i) { const float keep = up ? p[H + i] : p[i]; const float send = up ? p[i] : p[H + i]; p[i] = keep + shx(send, OFF, lane); }
        bfly_rec<H / 2, OFF / 2, NN>(p, lane);
    }
}
template <int N> __device__ __forceinline__ float bfly_reduce(float (&p)[N], int lane) {
    bfly_rec<N / 2, 32, N>(p, lane);
    float v = p[0];
#pragma unroll
    for (int off = (64 / N) / 2; off >= 1; off >>= 1) v += shx(v, off, lane);
    return v;
}

#define XB_TMO      128
#define XB_XCNT(j)  (256  + 64 * (j))
#define XB_XSUB(j)  (1280 + 64 * (j))
#define XB_XGEN(j)  (2304 + 64 * (j))
#define XB_TOP      3328
#define XB_TOPGEN   3392
#define XCD_BAR_WORDS 3456
#define XB_SPIN_CAP (1u << 20)
__device__ __forceinline__ unsigned xb_ld(unsigned* p)              { return __hip_atomic_load(p, __ATOMIC_RELAXED, __HIP_MEMORY_SCOPE_AGENT); }
__device__ __forceinline__ unsigned xb_add(unsigned* p, unsigned v) { return __hip_atomic_fetch_add(p, v, __ATOMIC_RELAXED, __HIP_MEMORY_SCOPE_AGENT); }
__device__ __forceinline__ unsigned xb_xcc_id() { return (unsigned)__builtin_amdgcn_s_getreg((3 << 11) | 20) & 0xFu; }
#define XB_SPIN(cond, bar) do { unsigned _sp = 0; while (cond) { __builtin_amdgcn_s_sleep(1); \
    if ((++_sp & 255u) == 0u) { if (xb_ld(&(bar)[XB_TMO])) break; if (_sp > XB_SPIN_CAP) { atomicAdd(&(bar)[XB_TMO], 1u); break; } } } } while (0)
struct XcdBarrier { unsigned* bar; unsigned x; volatile LAS unsigned* st; };
__device__ __forceinline__ XcdBarrier xcd_barrier_post(unsigned* bar, volatile LAS unsigned* st) {
    XcdBarrier b; b.bar = bar; b.x = xb_xcc_id(); b.st = st;
    if (threadIdx.x == 0) (void)xb_add(&bar[XB_XCNT(b.x)], 1u);
    return b;
}
__device__ __forceinline__ void xcd_barrier_complete(unsigned* bar, unsigned x, unsigned& nloc, unsigned& nx) {
    const unsigned G = gridDim.x * gridDim.y * gridDim.z;
    unsigned sum, cnt, mine, sp = 0u;
    for (;;) {
        sum = 0u; cnt = 0u; mine = 0u;
#pragma unroll
        for (unsigned j = 0; j < 16; ++j) { const unsigned c = xb_ld(&bar[XB_XCNT(j)]); sum += c; cnt += (c > 0u) ? 1u : 0u; mine = (j == x) ? c : mine; }
        if (sum == G) break;
        __builtin_amdgcn_s_sleep(1);
        if ((++sp & 255u) == 0u) { if (xb_ld(&bar[XB_TMO])) break; if (sp > XB_SPIN_CAP) { atomicAdd(&bar[XB_TMO], 1u); break; } }
    }
    nloc = mine > 0u ? mine : 1u; nx = cnt > 0u ? cnt : 1u;
}
__device__ __forceinline__ void xcd_barrier(const XcdBarrier& b) {
    asm volatile("s_waitcnt vmcnt(0)" ::: "memory");
    __syncthreads();
    if (threadIdx.x == 0) {
        unsigned* bar = b.bar;
        __builtin_amdgcn_s_waitcnt(0);
        unsigned nloc = b.st[0], nx = b.st[1];
        if (nloc == 0u) { xcd_barrier_complete(bar, b.x, nloc, nx); b.st[0] = nloc; b.st[1] = nx; }
        const unsigned old = xb_add(&bar[XB_XSUB(b.x)], 1u);
        const unsigned gen = old / nloc;
        if (old + 1u == (gen + 1u) * nloc) {
            __builtin_amdgcn_fence(__ATOMIC_RELEASE, "agent");
            asm volatile("s_waitcnt vmcnt(0)" ::: "memory");
            const unsigned og = xb_add(&bar[XB_TOP], 1u);
            const unsigned tg = og / nx;
            if (og + 1u == (tg + 1u) * nx) xb_add(&bar[XB_TOPGEN], 1u);
            else XB_SPIN(xb_ld(&bar[XB_TOPGEN]) == tg, bar);
            __builtin_amdgcn_fence(__ATOMIC_ACQUIRE, "agent");
            xb_add(&bar[XB_XGEN(b.x)], 1u);
            asm volatile("s_waitcnt vmcnt(0)" ::: "memory");
        } else {
            XB_SPIN(xb_ld(&bar[XB_XGEN(b.x)]) == gen, bar);
            __builtin_amdgcn_fence(__ATOMIC_ACQUIRE, "agent");
            asm volatile("s_waitcnt vmcnt(0)" ::: "memory");
        }
    }
    __syncthreads();
}

struct Frame {
    LAS unsigned char* lds;
    int G, bid;
    const float* const* in;
    float* out; unsigned char* ws;
};
#define WSP(T, off) ((T*)(F.ws + (off)))
#define LAUNDER_V(x) asm volatile("" : "+v"(x))
#define LAUNDER_S(x) asm volatile("" : "+s"(x))

namespace pg8 {
constexpr int BM = 256, BK = 64, HALF = 128, HTB = HALF * BK * 2, STAGE_BYTES = 8 * HTB, NXCD = 8, WGM = 8;
__host__ __device__ __forceinline__ int lds_byte(int r, int c) { const int st = (r >> 4) * 2 + (c >> 5), rr = r & 15, cc = c & 31, ob = rr * 64 + cc * 2; return st * 1024 + (ob ^ (((ob >> 9) & 1) << 5)); }
__host__ __device__ __forceinline__ void stage_rc(int b, int& R, int& C) { const int st = b / 1024, sb = b % 1024, swz = sb ^ (((sb >> 9) & 1) << 5); R = (st >> 1) * 16 + swz / 64; C = (st & 1) * 32 + (swz % 64) / 2; }
__host__ __device__ __forceinline__ int perm32(int rho) { const int n = rho >> 4, i = rho & 15; return 8 * (i >> 2) + 4 * n + (i & 3); }

struct Unit { const char* a; const char* b; int pm, pn, e, aux; };
__device__ __forceinline__ void tile_of(int L, int nM, int nN, int& pm, int& pn) {
    const int nwg = nM * nN; int wgid = L; { const int q = nwg / NXCD, r = nwg % NXCD, xcd = wgid % NXCD, off = wgid / NXCD; wgid = (xcd < r ? xcd * (q + 1) : r * (q + 1) + (xcd - r) * q) + off; }
    const int nig = WGM * nN, gid = wgid / nig, fm = gid * WGM, gsz = (nM - fm) < WGM ? (nM - fm) : WGM;
    pm = fm + ((wgid % nig) % gsz); pn = (wgid % nig) / gsz;
}

template <class Epi, class Sched, bool QUAD = false>
__device__ __forceinline__ void gemm_phase(LAS unsigned char* lds, const int K, const unsigned lda, const unsigned ldb, const Sched& S, const Epi& E) {
    int tid = threadIdx.x; LAUNDER_V(tid);
    const int wid = __builtin_amdgcn_readfirstlane(tid >> 6), lane = tid & 63, wr = wid >> 2, wc = wid & 3, fr = lane & 15, fq = lane >> 4;
    const int nt = K / BK;
    unsigned voffB[2]; int sR[2], sC[2];
#pragma unroll
    for (int i = 0; i < 2; ++i) { int R, C; stage_rc(tid * 16 + i * 8192, R, C); const int Rb = Epi::PERM ? ((R & ~31) + perm32(R & 31)) : R;
        sR[i] = R; sC[i] = C; voffB[i] = (unsigned)Rb * ldb + (unsigned)C * 2u; }
    unsigned voffA[2][2];
    const size_t kstep = (size_t)(BK * 2);
    const size_t hstepB = S.hstep_b(ldb);
    const unsigned ldsw = (unsigned)wid * 1024u;
    const int aoff = lds_byte(wr * 64 + fr, fq * 8), boff = lds_byte(wc * 32 + fr, fq * 8);
#define PG8_SA(b, h) (((b) * 2 + (h)) * HTB)
#define PG8_SB(b, h) ((4 + (b) * 2 + (h)) * HTB)
#define PG8_STAGE(bufoff, gbase, voff) do { _Pragma("unroll") for (int _i = 0; _i < 2; ++_i) \
        __builtin_amdgcn_global_load_lds((const unsigned*)((const char*)(gbase) + (voff)[_i]), (LAS unsigned*)(lds + (bufoff) + ldsw + _i * 8192), 16, 0, 0); } while (0)
#define PG8_LDA(dst, b, h) do { _Pragma("unroll") for (int m = 0; m < 4; ++m) _Pragma("unroll") for (int k = 0; k < 2; ++k) dst[m][k] = *(const LAS bf16x8*)(lds + PG8_SA(b, h) + aoff + m * 2048 + k * 1024); } while (0)
#define PG8_LDB(dst, b, h) do { _Pragma("unroll") for (int n = 0; n < 2; ++n) _Pragma("unroll") for (int k = 0; k < 2; ++k) dst[n][k] = *(const LAS bf16x8*)(lds + PG8_SB(b, h) + boff + n * 2048 + k * 1024); } while (0)
#define PG8_MMA(ai, bj, At, Bt) do { __builtin_amdgcn_s_setprio(1); _Pragma("unroll") for (int m = 0; m < 4; ++m) _Pragma("unroll") for (int n = 0; n < 2; ++n) _Pragma("unroll") for (int k = 0; k < 2; ++k) \
        acc[ai][bj][m][n] = __builtin_amdgcn_mfma_f32_16x16x32_bf16(Bt[n][k], At[m][k], acc[ai][bj][m][n], 0, 0, 0); __builtin_amdgcn_s_setprio(0); } while (0)
#define PG8_WAIT_V(n) asm volatile("s_waitcnt vmcnt(" #n ")" ::: "memory")
#define PG8_WAIT_L(n) asm volatile("s_waitcnt lgkmcnt(" #n ")" ::: "memory")
#define PG8_BAR __builtin_amdgcn_s_barrier()
#define PG8_SCHED __builtin_amdgcn_sched_barrier(0)
    Unit cur, nxt; int ui = 0;
    if (!S.next(0, cur)) return;
    f32x4 acc[2][2][4][2];
#pragma unroll
    for (int a = 0; a < 2; ++a)
#pragma unroll
        for (int b = 0; b < 2; ++b)
#pragma unroll
            for (int m = 0; m < 4; ++m)
#pragma unroll
                for (int n = 0; n < 2; ++n) acc[a][b][m][n] = (f32x4){0.f, 0.f, 0.f, 0.f};
    bf16x8 At[4][2], B0[2][2], B1[2][2];
    const char* cA = cur.a; const char* cB = cur.b;
    S.aoff(cur, sR, sC, lda, voffA);
    PG8_STAGE(PG8_SB(0, 0), cB, voffB); PG8_STAGE(PG8_SB(0, 1), cB + hstepB, voffB); PG8_STAGE(PG8_SA(0, 0), cA, voffA[0]); PG8_STAGE(PG8_SA(0, 1), cA, voffA[1]);
    if (wr == 1) PG8_BAR;
    PG8_WAIT_V(2); PG8_BAR;
    PG8_STAGE(PG8_SB(1, 0), cB + kstep, voffB); PG8_STAGE(PG8_SA(1, 0), cA + kstep, voffA[0]); PG8_STAGE(PG8_SB(1, 1), cB + hstepB + kstep, voffB);
    PG8_WAIT_V(6); PG8_BAR;
    for (;;) {
        const bool has_next = S.next(ui + 1, nxt);
        const char* nA = has_next ? nxt.a : cA; const char* nB = has_next ? nxt.b : cB;
#define PG8_TRIP(MMA_A0, MMA_A1) { \
            const bool last = (t == nt - 2); \
            const char* a1 = cA + (size_t)(t + 1) * kstep; \
            const char* a2 = last ? nA : cA + (size_t)(t + 2) * kstep; const char* b2 = last ? nB : cB + (size_t)(t + 2) * kstep; \
            const char* a3 = a2 + kstep; const char* b3 = b2 + kstep; \
            PG8_LDB(B0, 0, 0); PG8_LDB(B1, 0, 1); PG8_SCHED; PG8_LDA(At, 0, 0); PG8_STAGE(PG8_SA(1, 1), a1, voffA[1]); \
            if (last && has_next) S.aoff(nxt, sR, sC, lda, voffA);     \
            PG8_WAIT_V(8); PG8_WAIT_L(0); PG8_BAR; MMA_A0; PG8_BAR; PG8_SCHED; \
            PG8_LDA(At, 0, 1); PG8_STAGE(PG8_SB(0, 0), b2, voffB); PG8_STAGE(PG8_SB(0, 1), b2 + hstepB, voffB); PG8_STAGE(PG8_SA(0, 0), a2, voffA[0]); \
            PG8_WAIT_V(8); PG8_WAIT_L(0); PG8_BAR; MMA_A1; PG8_BAR; PG8_SCHED; \
            PG8_LDB(B0, 1, 0); PG8_LDB(B1, 1, 1); PG8_SCHED; PG8_LDA(At, 1, 0); PG8_STAGE(PG8_SA(0, 1), a2, voffA[1]); \
            PG8_WAIT_V(8); PG8_WAIT_L(0); PG8_BAR; MMA_A0; PG8_BAR; PG8_SCHED; \
            PG8_LDA(At, 1, 1); PG8_STAGE(PG8_SB(1, 0), b3, voffB); PG8_STAGE(PG8_SB(1, 1), b3 + hstepB, voffB); PG8_STAGE(PG8_SA(1, 0), a3, voffA[0]); \
            PG8_WAIT_V(8); PG8_WAIT_L(0); PG8_BAR; MMA_A1; PG8_BAR; PG8_SCHED; }
        if constexpr (!QUAD) {
            for (int t = 0; t < nt; t += 2) PG8_TRIP({ PG8_MMA(0, 0, At, B0); PG8_MMA(0, 1, At, B1); }, { PG8_MMA(1, 0, At, B0); PG8_MMA(1, 1, At, B1); })
        } else {
            int t = 0;
            for (; 2 * t < nt; t += 2) PG8_TRIP({ PG8_MMA(0, 0, At, B0); }, { PG8_MMA(1, 1, At, B1); })
            for (; t < nt; t += 2) PG8_TRIP({ PG8_MMA(0, 1, At, B1); }, { PG8_MMA(1, 0, At, B0); })
        }
#undef PG8_TRIP
        if (wr == 0) PG8_BAR;
        E(acc, cur, wr, wc, fr, fq);
        if (!has_next) break;
#pragma unroll
        for (int a = 0; a < 2; ++a)
#pragma unroll
            for (int b = 0; b < 2; ++b)
#pragma unroll
                for (int m = 0; m < 4; ++m)
#pragma unroll
                    for (int n = 0; n < 2; ++n) acc[a][b][m][n] = (f32x4){0.f, 0.f, 0.f, 0.f};
        cur = nxt; cA = nA; cB = nB; ++ui;
        if (wr == 1) PG8_BAR;
    }
    PG8_WAIT_V(0);
    PG8_BAR;
#undef PG8_SA
#undef PG8_SB
#undef PG8_STAGE
#undef PG8_LDA
#undef PG8_LDB
#undef PG8_MMA
#undef PG8_WAIT_V
#undef PG8_WAIT_L
#undef PG8_BAR
#undef PG8_SCHED
}
}

struct SchedGrid {
    int nM, nN, G, c, pm0; const char* A; const char* B; size_t ta, tb;
    __device__ __forceinline__ size_t hstep_b(unsigned ldb) const { return (size_t)128 * ldb; }
    __device__ __forceinline__ bool next(int i, pg8::Unit& u) const {
        const long L = (long)i * G + c; if (L >= (long)nM * nN) return false;
        int pm, pn; pg8::tile_of((int)L, nM, nN, pm, pn); pm += pm0;
        u.pm = pm; u.pn = pn; u.e = 0; u.aux = 0; u.a = A + (size_t)pm * ta; u.b = B + (size_t)pn * tb; return true;
    }
    __device__ __forceinline__ void aoff(const pg8::Unit&, const int (&R)[2], const int (&C)[2], unsigned lda, unsigned (&vo)[2][2]) const {
#pragma unroll
        for (int h = 0; h < 2; ++h)
#pragma unroll
            for (int i = 0; i < 2; ++i) vo[h][i] = (unsigned)(h * 128 + R[i]) * lda + (unsigned)C[i] * 2u; }
};
struct SchedQuad {
    int nM, nN, G, c, tm0; const char* A; const char* B;
    __device__ __forceinline__ size_t hstep_b(unsigned) const { return (size_t)1024 * 2048; }
    __device__ __forceinline__ bool next(int i, pg8::Unit& u) const {
        const long L = (long)i * G + c; if (L >= (long)nM * nN) return false;
        int tm, tn; pg8::tile_of((int)L, nM, nN, tm, tn); tm += tm0;
        u.pm = tm; u.pn = tn; u.e = 0; u.aux = 0; u.a = A + (size_t)tm * 128 * 4096; u.b = B + (size_t)tn * 128 * 2048; return true;
    }
    __device__ __forceinline__ void aoff(const pg8::Unit&, const int (&R)[2], const int (&C)[2], unsigned lda, unsigned (&vo)[2][2]) const {
#pragma unroll
        for (int h = 0; h < 2; ++h)
#pragma unroll
            for (int i = 0; i < 2; ++i) vo[h][i] = (unsigned)R[i] * lda + (unsigned)(h * 1024 + C[i]) * 2u; }
};
__device__ __forceinline__ bool moe_unit(int i, int c, int G, int nN, int total, int& mtg, int& pn) {
    const int per = G >> 3, x = c & 7, r = c >> 3;
    if ((G & 7) != 0 || r >= per) { const long L = (long)i * G + c; mtg = (int)(L / nN); pn = (int)(L % nN); return mtg < total; }
    const int n = i * per + r; mtg = x + 8 * (n / nN); pn = n % nN; return mtg < total;
}
struct SchedMoe {
    const LAS int* tstart; const LAS unsigned short* toks; int nN, G, c; const char* A; const char* B; size_t ta, tb, eb;
    __device__ __forceinline__ size_t hstep_b(unsigned ldb) const { return (size_t)128 * ldb; }
    __device__ __forceinline__ bool next(int i, pg8::Unit& u) const {
        const int total = tstart[32]; int mtg, pn;
        if (!moe_unit(i, c, G, nN, total, mtg, pn)) return false;
        int e = 0;
#pragma unroll 1
        for (int k = 1; k < 32; ++k) e += (tstart[k] <= mtg) ? 1 : 0;
        u.pm = mtg; u.pn = pn; u.e = e; u.aux = (mtg - tstart[e]) | (i << 16);
        u.a = A + (size_t)mtg * ta; u.b = B + (size_t)e * eb + (size_t)pn * tb; return true;
    }
    __device__ __forceinline__ void aoff(const pg8::Unit& u, const int (&R)[2], const int (&C)[2], unsigned lda, unsigned (&vo)[2][2]) const {
        const int ord = u.aux >> 16;
#pragma unroll
        for (int h = 0; h < 2; ++h)
#pragma unroll
            for (int i = 0; i < 2; ++i) { const unsigned row = toks ? (unsigned)toks[ord * 256 + h * 128 + R[i]] : (unsigned)(h * 128 + R[i]); vo[h][i] = row * lda + (unsigned)C[i] * 2u; }
    }
};

struct EpiProj {
    static constexpr bool PERM = true;
    bf16_t* O; const float* rcos; const float* rsin; unsigned char* g8;
    __device__ __forceinline__ void operator()(const f32x4 (&acc)[2][2][4][2], const pg8::Unit& u, int wr, int wc, int fr, int fq) const {
        const int row0 = u.pm * 256 + wr * 64 + fr, col0 = u.pn * 256 + wc * 32 + 8 * fq;
        if (u.pn >= C_MG / 256) {
#pragma unroll
            for (int ai = 0; ai < 2; ++ai)
#pragma unroll
                for (int m = 0; m < 4; ++m) {
                    unsigned char* rowp = g8 + (size_t)(row0 + ai * 128 + m * 16) * 4096 + (col0 - C_MG);
#pragma unroll
                    for (int bj = 0; bj < 2; ++bj) {
                        unsigned q[8];
#pragma unroll
                        for (int n = 0; n < 2; ++n) {
                            const f32x4 tt = acc[ai][bj][m][n] * -1.4426950408889634f; f32x4 ee, rr;
#pragma unroll
                            for (int j = 0; j < 4; ++j) ee[j] = __builtin_amdgcn_exp2f(tt[j]);
                            ee = ee + 1.0f;
#pragma unroll
                            for (int j = 0; j < 4; ++j) rr[j] = __builtin_amdgcn_rcpf(ee[j]);
                            rr = rr * 255.0f + 0.5f;
#pragma unroll
                            for (int j = 0; j < 4; ++j) q[4 * n + j] = (unsigned)rr[j]; }
                        u32x2 w; w.x = q[0] | (q[1] << 8) | (q[2] << 16) | (q[3] << 24); w.y = q[4] | (q[5] << 8) | (q[6] << 16) | (q[7] << 24);
                        *(u32x2*)(rowp + bj * 128) = w;
                    }
                }
            return;
        }
        const bool qk = (u.pn >= 4) && (u.pn < 8) && (u.pm >= 16);
        const bool isq = (u.pn == 4) || (u.pn == 5);
        const float sgn = (fq < 2) ? -1.f : 1.f;
#pragma unroll
        for (int ai = 0; ai < 2; ++ai)
#pragma unroll
            for (int m = 0; m < 4; ++m) {
                const int row = row0 + ai * 128 + m * 16;
                f32x4 c0 = {1.f, 1.f, 1.f, 1.f}, c1 = c0, s0 = {0.f, 0.f, 0.f, 0.f}, s1 = s0;
                if (qk) { const int t = (row - NCTX) & (SEQ - 1); const int p = (wc & 1) ? (t & 63) : (t >> 6); const int f0 = p * 16 + 8 * (fq & 1);
                    c0 = *(const f32x4*)(rcos + f0); c1 = *(const f32x4*)(rcos + f0 + 4); s0 = *(const f32x4*)(rsin + f0); s1 = *(const f32x4*)(rsin + f0 + 4); }
                bf16_t* rowp = O + (size_t)row * PW + col0;
#pragma unroll
                for (int bj = 0; bj < 2; ++bj) {
                    f32x4 v0 = acc[ai][bj][m][0], v1 = acc[ai][bj][m][1];
                    if (qk) {
                        f32x4 p0, p1;
#pragma unroll
                        for (int j = 0; j < 4; ++j) { p0[j] = shx(v0[j], 32, fq * 16 + fr); p1[j] = shx(v1[j], 32, fq * 16 + fr); }
                        v0 = v0 * c0 + (p0 * s0) * sgn; v1 = v1 * c1 + (p1 * s1) * sgn;
                    }
                    if (isq) { v0 = v0 * QSCALE; v1 = v1 * QSCALE; }
                    u32x4 w; w.x = cvt_pk_bf16(v0[0], v0[1]); w.y = cvt_pk_bf16(v0[2], v0[3]); w.z = cvt_pk_bf16(v1[0], v1[1]); w.w = cvt_pk_bf16(v1[2], v1[3]);
                    *(u32x4*)(rowp + bj * 128) = w;
                }
                __builtin_amdgcn_sched_barrier(0);
            }
    }
};
struct EpiQuad {
    static constexpr bool PERM = false;
    const unsigned char* g8; bf16_t* mout;
    __device__ __forceinline__ void operator()(const f32x4 (&acc)[2][2][4][2], const pg8::Unit& u, int wr, int wc, int fr, int fq) const {
        const int row0 = u.pm * 128 + wr * 64 + fr, col0 = u.pn * 128 + wc * 32 + 4 * fq;
#pragma unroll
        for (int mh = 0; mh < 2; ++mh) {
            unsigned g4[2][2][4];
#pragma unroll
            for (int mm = 0; mm < 2; ++mm)
#pragma unroll
                for (int n = 0; n < 2; ++n)
#pragma unroll
                    for (int br = 0; br < 4; ++br) g4[mm][n][br] = *(const unsigned*)(g8 + (size_t)(row0 + (2 * mh + mm) * 16) * 4096 + col0 + n * 16 + br * 1024);
            asm volatile("" ::: "memory");
#pragma unroll
            for (int mm = 0; mm < 2; ++mm) {
                const int m = 2 * mh + mm, row = row0 + m * 16;
#pragma unroll
                for (int n = 0; n < 2; ++n) {
                    const int col = col0 + n * 16;
                    f32x4 v = {0.f, 0.f, 0.f, 0.f};
#pragma unroll
                    for (int br = 0; br < 4; ++br) {
                        const f32x4 p = (br == 0) ? acc[0][0][m][n] : (br == 1) ? acc[1][1][m][n] : (br == 2) ? acc[0][1][m][n] : acc[1][0][m][n];
                        const unsigned gw = g4[mm][n][br];
                        f32x4 g; g[0] = (float)(gw & 255u); g[1] = (float)((gw >> 8) & 255u); g[2] = (float)((gw >> 16) & 255u); g[3] = (float)(gw >> 24);
                        v += g * p;
                    }
                    v = v * (1.0f / 255.0f);
                    u32x2 w; w.x = cvt_pk_bf16(v[0], v[1]); w.y = cvt_pk_bf16(v[2], v[3]); *(u32x2*)(mout + (size_t)row * 1024 + col) = w;
                }
            }
        }
    }
};
struct EpiOut {
    static constexpr bool PERM = true;
    bf16_t* yb; const float* mod;
    __device__ __forceinline__ void operator()(const f32x4 (&acc)[2][2][4][2], const pg8::Unit& u, int wr, int wc, int fr, int fq) const {
        const int row0 = u.pm * 256 + wr * 64 + fr, col0 = u.pn * 256 + wc * 32 + 8 * fq;
        const int mr = (u.pm < 16) ? 16 : ((u.pm - 16) >> 3);
        const float* gp = mod + (size_t)mr * 6144 + 2048 + col0;
        f32x4 g[2][2];
#pragma unroll
        for (int bj = 0; bj < 2; ++bj) { g[bj][0] = *(const f32x4*)(gp + bj * 128); g[bj][1] = *(const f32x4*)(gp + bj * 128 + 4); }
#pragma unroll
        for (int ai = 0; ai < 2; ++ai)
#pragma unroll
            for (int m = 0; m < 4; ++m) {
                bf16_t* rowp = yb + (size_t)(row0 + ai * 128 + m * 16) * 1024 + col0;
#pragma unroll
                for (int bj = 0; bj < 2; ++bj) { const f32x4 v0 = acc[ai][bj][m][0] * g[bj][0], v1 = acc[ai][bj][m][1] * g[bj][1];
                    u32x4 w; w.x = cvt_pk_bf16(v0[0], v0[1]); w.y = cvt_pk_bf16(v0[2], v0[3]); w.z = cvt_pk_bf16(v1[0], v1[1]); w.w = cvt_pk_bf16(v1[2], v1[3]);
                    *(u32x4*)(rowp + bj * 128) = w; }
            }
    }
};
struct EpiGU {
    static constexpr bool PERM = true;
    bf16_t* hid; const float* bgu;
    __device__ __forceinline__ void operator()(const f32x4 (&acc)[2][2][4][2], const pg8::Unit& u, int wr, int wc, int fr, int fq) const {
        const int row0 = u.pm * 256 + wr * 64 + fr, hc0 = u.pn * 128 + wc * 32 + 8 * fq;
        const float* bp = bgu + (size_t)u.e * 2048 + hc0;
        const f32x4 bg0 = *(const f32x4*)bp, bg1 = *(const f32x4*)(bp + 4), bu0 = *(const f32x4*)(bp + 1024), bu1 = *(const f32x4*)(bp + 1028);
#pragma unroll
        for (int ai = 0; ai < 2; ++ai)
#pragma unroll
            for (int m = 0; m < 4; ++m) {
                const int row = row0 + ai * 128 + m * 16;
                f32x4 o[2];
#pragma unroll
                for (int n = 0; n < 2; ++n) {
                    const f32x4 g = acc[ai][0][m][n] + (n ? bg1 : bg0), up = acc[ai][1][m][n] + (n ? bu1 : bu0);
                    f32x4 gg, uu;
#pragma unroll
                    for (int j = 0; j < 4; ++j) { gg[j] = fminf(g[j], 7.f); uu[j] = fminf(fmaxf(up[j], -7.f), 7.f); }
                    const f32x4 tt = gg * (-1.702f * 1.4426950408889634f);
                    f32x4 ee;
#pragma unroll
                    for (int j = 0; j < 4; ++j) ee[j] = __builtin_amdgcn_exp2f(tt[j]);
                    ee = ee + 1.0f;
                    f32x4 rr;
#pragma unroll
                    for (int j = 0; j < 4; ++j) rr[j] = __builtin_amdgcn_rcpf(ee[j]);
                    o[n] = (uu + 1.0f) * (gg * rr);
                }
                u32x4 w; w.x = cvt_pk_bf16(o[0][0], o[0][1]); w.y = cvt_pk_bf16(o[0][2], o[0][3]); w.z = cvt_pk_bf16(o[1][0], o[1][1]); w.w = cvt_pk_bf16(o[1][2], o[1][3]);
                *(u32x4*)(hid + (size_t)row * 1024 + hc0) = w;
            }
    }
};
struct EpiDown {
    static constexpr bool PERM = true;
    unsigned char* y2; const float* bd; const int* elist; const unsigned* ecnt;
    __device__ __forceinline__ void operator()(const f32x4 (&acc)[2][2][4][2], const pg8::Unit& u, int wr, int wc, int fr, int fq) const {
        const int lr0 = wr * 64 + fr, col0 = u.pn * 256 + wc * 32 + 8 * fq;
        const int cnt = (int)ecnt[u.e * 64]; const int pos0 = (u.aux & 0xffff) * 256;
        const float* bp = bd + (size_t)u.e * 1024 + col0;
        f32x4 b[2][2];
#pragma unroll
        for (int bj = 0; bj < 2; ++bj) { b[bj][0] = *(const f32x4*)(bp + bj * 128); b[bj][1] = *(const f32x4*)(bp + bj * 128 + 4); }
        int tk[2][4];
#pragma unroll
        for (int ai = 0; ai < 2; ++ai)
#pragma unroll
            for (int m = 0; m < 4; ++m) { const int pos = pos0 + lr0 + ai * 128 + m * 16; tk[ai][m] = elist[(size_t)u.e * ECAP + (pos < cnt ? pos : 0)]; }
        asm volatile("" ::: "memory");
#pragma unroll
        for (int ai = 0; ai < 2; ++ai)
#pragma unroll
            for (int m = 0; m < 4; ++m) {
                const int pos = pos0 + lr0 + ai * 128 + m * 16;
                if (pos < cnt) {
                    const int tok4 = tk[ai][m];
                    unsigned char* rowp = y2 + (size_t)tok4 * 1024 + col0;
#pragma unroll
                    for (int bj = 0; bj < 2; ++bj) {
                        const f32x4 v0 = acc[ai][bj][m][0] + b[bj][0], v1 = acc[ai][bj][m][1] + b[bj][1];
                        u32x2 w; int t0 = __builtin_amdgcn_cvt_pk_fp8_f32(v0[0], v0[1], 0, false); t0 = __builtin_amdgcn_cvt_pk_fp8_f32(v0[2], v0[3], t0, true);
                        int t1 = __builtin_amdgcn_cvt_pk_fp8_f32(v1[0], v1[1], 0, false); t1 = __builtin_amdgcn_cvt_pk_fp8_f32(v1[2], v1[3], t1, true);
                        w.x = (unsigned)t0; w.y = (unsigned)t1; *(u32x2*)(rowp + bj * 128) = w;
                    }
                }
            }
    }
};

#define LDS_WAIT() asm volatile("s_waitcnt lgkmcnt(0)" ::: "memory")
#define LDS_BARRIER() asm volatile("s_waitcnt lgkmcnt(0)\n\ts_barrier" ::: "memory")
__device__ __forceinline__ void tr_item(const float* W, int ldn, int K, bf16_t* WT, int k0, int n0s, int r0, LAS float* scr, int lane, int kd0 = 0) {
    const int l15 = lane & 15, l4 = lane >> 4;
    const float* src = W + (size_t)(k0 + l4) * ldn + n0s + 4 * l15;
    f32x4 v[16];
#pragma unroll
    for (int i = 0; i < 16; ++i) v[i] = *(const f32x4*)(src + (size_t)(4 * i) * ldn);
    asm volatile("" ::: "memory");
#pragma unroll
    for (int i = 0; i < 16; ++i) { LAS float* d = scr + (4 * l15) * 65 + 4 * i + l4; d[0] = v[i][0]; d[65] = v[i][1]; d[130] = v[i][2]; d[195] = v[i][3]; }
    LDS_WAIT(); asm volatile("" ::: "memory");
    const int c = lane & 7;
#pragma unroll
    for (int j = 0; j < 8; ++j) { const int n = (lane >> 3) + 8 * j; const LAS float* s = scr + n * 65 + 8 * c;
        u32x4 o; o.x = cvt_pk_bf16(s[0], s[1]); o.y = cvt_pk_bf16(s[2], s[3]); o.z = cvt_pk_bf16(s[4], s[5]); o.w = cvt_pk_bf16(s[6], s[7]);
        *(u32x4*)(WT + (size_t)(r0 + n) * K + kd0 + k0 + 8 * c) = o; }
    LDS_WAIT(); asm volatile("" ::: "memory");
}
__device__ __forceinline__ void p0_weights(Frame& F) {
    int tid_ = threadIdx.x; LAUNDER_V(tid_); const int lane_ = tid_ & 63, wave_ = __builtin_amdgcn_readfirstlane(tid_ >> 6); (void)lane_; (void)wave_;
    for (int task = F.bid; task < DEPTH * 4 * 16; task += F.G) {
        const int kb = task & 15, g = (task >> 4) & 3, li = task >> 6;
        LAS float* wl = (LAS float*)F.lds;
        LAS float* pl = wl + 64 * 129;
        const float* wsrc = F.in[6] + ((size_t)li * 1024 + kb * 64) * INW + C_PU + g * 128; const float* psrc = F.in[16] + (size_t)(li * 4 + g) * 128 * 128;
        f32x4 wv[4], pv[8];
#pragma unroll
        for (int i = 0; i < 4; ++i) wv[i] = *(const f32x4*)(wsrc + (size_t)((tid_ >> 5) + 16 * i) * INW + 4 * (tid_ & 31));
#pragma unroll
        for (int i = 0; i < 8; ++i) pv[i] = *(const f32x4*)(psrc + (size_t)(tid_ + 512 * i) * 4);
#pragma unroll
        for (int i = 0; i < 4; ++i) { LAS float* d = wl + ((tid_ >> 5) + 16 * i) * 129 + 4 * (tid_ & 31); d[0] = wv[i][0]; d[1] = wv[i][1]; d[2] = wv[i][2]; d[3] = wv[i][3]; }
#pragma unroll
        for (int i = 0; i < 8; ++i) *(LAS f32x4*)(pl + (tid_ + 512 * i) * 4) = pv[i];
        __syncthreads();
        const int k = tid_ & 63, eb = wave_;
        f32x4 a0 = {0.f, 0.f, 0.f, 0.f}, a1 = a0, a2 = a0, a3 = a0;
#pragma unroll 4
        for (int c = 0; c < 128; ++c) { const float w = wl[k * 129 + c]; const LAS f32x4* p = (const LAS f32x4*)(pl + c * 128 + eb * 16);
            a0 += p[0] * w; a1 += p[1] * w; a2 += p[2] * w; a3 += p[3] * w; }
        bf16_t* dst = WSP(bf16_t, WS_WIN) + ((size_t)li * PW + C_PU + g * 128 + eb * 16) * 1024 + kb * 64 + k;
#pragma unroll
        for (int j = 0; j < 4; ++j) { dst[(size_t)j * 1024] = f2bf(a0[j]); dst[(size_t)(4 + j) * 1024] = f2bf(a1[j]); dst[(size_t)(8 + j) * 1024] = f2bf(a2[j]); dst[(size_t)(12 + j) * 1024] = f2bf(a3[j]); }
        __syncthreads();
    }
    LAS float* scr = (LAS float*)(F.lds + wave_ * 16640);
    const int gw = F.bid * NWAVES + wave_, NGW = F.G * NWAVES, lane = lane_;
    constexpr int I_IN = 16 * (PW / 64), I_GU = 16 * 32, I_DN = 16 * 16, I_BR = 8 * 16, I_OUT = 16 * 16, I_RNN = 1;
    constexpr int N_IN = DEPTH * I_IN, N_GU = DEPTH * 32 * I_GU, N_DN = DEPTH * 32 * I_DN, N_BR = DEPTH * 4 * I_BR, N_OUT = DEPTH * I_OUT, N_RNN = DEPTH * 2 * 8 * I_RNN;
    constexpr int NITEMS = N_IN + N_GU + N_DN + N_BR + N_OUT + 2 * N_RNN;
    for (int it = gw; it < NITEMS; it += NGW) {
        int r = it;
        if (r < N_GU) { const int mat = r / I_GU, q = r % I_GU, kb = q / 32, rb = q % 32; const int r0 = rb * 64; const int pn = r0 >> 8, half = (r0 >> 7) & 1, jj = r0 & 127;
            tr_item(F.in[33] + (size_t)mat * 1024 * 2048, 2048, 1024, WSP(bf16_t, WS_WGU) + (size_t)mat * 2048 * 1024, kb * 64, half * 1024 + pn * 128 + jj, r0, scr, lane); continue; } r -= N_GU;
        if (r < N_DN) { const int mat = r / I_DN, q = r % I_DN, kb = q / 16, rb = q % 16;
            tr_item(F.in[35] + (size_t)mat * 1024 * 1024, 1024, 1024, WSP(bf16_t, WS_WD) + (size_t)mat * 1024 * 1024, kb * 64, rb * 64, rb * 64, scr, lane); continue; } r -= N_DN;
        if (r < N_IN) { const int mat = r / I_IN, q = r % I_IN, kb = q / (PW / 64), rb = q % (PW / 64); const int r0 = rb * 64;
            if (r0 >= C_PU && r0 < C_PU + 512) continue;
            tr_item(F.in[6] + (size_t)mat * 1024 * INW, INW, 1024, WSP(bf16_t, WS_WIN) + (size_t)mat * PW * 1024, kb * 64, r0 < C_MG ? r0 : r0 + 16, r0, scr, lane); continue; } r -= N_IN;
        if (r < N_BR) { const int mat = r / I_BR, q = r % I_BR, kb = q / 16, rb = q % 16;
            { const int lay = mat >> 2, br = mat & 3; const int hq = (br == 1 || br == 2) ? 1 : 0, sq = (br >= 2) ? 1 : 0;
              tr_item(F.in[25] + (size_t)mat * 512 * 1024, 1024, 1024, WSP(bf16_t, WS_WBR) + ((size_t)lay * 2 + hq) * 1024 * 1024, kb * 64, rb * 64, rb * 64, scr, lane, sq * 512); } continue; } r -= N_BR;
        if (r < N_OUT) { const int mat = r / I_OUT, q = r % I_OUT, kb = q / 16, rb = q % 16;
            tr_item(F.in[26] + (size_t)mat * 1024 * 1024, 1024, 1024, WSP(bf16_t, WS_WOUT) + (size_t)mat * 1024 * 1024, kb * 64, rb * 64, rb * 64, scr, lane); continue; } r -= N_OUT;
        {
            const int gate = r / N_RNN; r %= N_RNN; const int mat = r; const int ld = mat / 8, h = mat % 8;
            tr_item(F.in[gate ? 11 : 9] + (size_t)mat * 64 * 64, 64, 64, WSP(bf16_t, WS_RNNW) + ((size_t)(ld * 2 + gate) * 8 + h) * 64 * 64, 0, 0, 0, scr, lane);
        }
    }
    const int gt = F.bid * NTHREADS + tid_, NGT = F.G * NTHREADS;
    for (int i = gt; i < DEPTH * 16 * 1024; i += NGT) { const int li = i >> 14, j = (i >> 10) & 15, k = i & 1023; WSP(float, WS_WDT)[i] = F.in[6][((size_t)li * 1024 + k) * INW + C_MG + j]; }
    for (int i = gt; i < DEPTH * 32 * 1024; i += NGT) { const int li = i >> 15, e = (i >> 10) & 31, k = i & 1023; WSP(float, WS_ROUT)[i] = F.in[31][((size_t)li * 1024 + k) * 32 + e]; }
    for (int i = gt; i < 64 * 16; i += NGT) { const int p = i >> 4, f = i & 15; const float inv = powf(10000.0f, -(float)f / 16.0f); const float ang = (float)p * inv;
        WSP(float, WS_ROPE)[i] = cosf(ang); WSP(float, WS_ROPE)[1024 + i] = sinf(ang); }
}
__device__ __forceinline__ void p0_mod(Frame& F) {
    int tid_ = threadIdx.x; LAUNDER_V(tid_); const int lane_ = tid_ & 63, wave_ = __builtin_amdgcn_readfirstlane(tid_ >> 6); (void)lane_; (void)wave_;
    __syncthreads();
    LAS float* sc = (LAS float*)F.lds;
    LAS float* red = sc + 17440;
    for (int i = tid_; i < 17 * 1024; i += NTHREADS) { const int r = i >> 10, k = i & 1023; const float v = r < 16 ? F.in[1][r * 1024 + k] : F.in[3][k]; sc[r * 1025 + k] = siluf_(v); }
    __syncthreads();
    const int m = lane_ & 31, kk = lane_ >> 5;
    for (int cb = F.bid; cb < 256; cb += F.G) {
        const int li = cb >> 6, j0 = (cb & 63) * 96;
        f32x16 acc0, acc1, acc2;
#pragma unroll
        for (int j = 0; j < 16; ++j) { acc0[j] = 0.f; acc1[j] = 0.f; acc2[j] = 0.f; }
        const float* wp = F.in[4] + ((size_t)li * 1024 + wave_ * 128 + kk) * 6144 + j0 + m;
        const LAS float* ap = sc + (m < 17 ? m : 0) * 1025 + wave_ * 128 + kk;
#pragma unroll 1
        for (int kb = 0; kb < 64; kb += 16) {
            float w0[16], w1[16], w2[16], av[16];
#pragma unroll
            for (int i = 0; i < 16; ++i) { const float* p = wp + (size_t)(2 * (kb + i)) * 6144; w0[i] = p[0]; w1[i] = p[32]; w2[i] = p[64]; }
#pragma unroll
            for (int i = 0; i < 16; ++i) { const float a = ap[2 * (kb + i)]; av[i] = m < 17 ? a : 0.f; }
#pragma unroll
            for (int i = 0; i < 16; ++i) {
                acc0 = __builtin_amdgcn_mfma_f32_32x32x2f32(av[i], w0[i], acc0, 0, 0, 0);
                acc1 = __builtin_amdgcn_mfma_f32_32x32x2f32(av[i], w1[i], acc1, 0, 0, 0);
                acc2 = __builtin_amdgcn_mfma_f32_32x32x2f32(av[i], w2[i], acc2, 0, 0, 0); }
        }
        LAS float* rw = red + wave_ * (3 * 9 * 64) + lane_;
#pragma unroll
        for (int j = 0; j < 9; ++j) { rw[(0 * 9 + j) * 64] = acc0[j]; rw[(1 * 9 + j) * 64] = acc1[j]; rw[(2 * 9 + j) * 64] = acc2[j]; }
        __syncthreads();
        for (int o = tid_; o < 3 * 9 * 64; o += NTHREADS) { const int l = o & 63, j = (o >> 6) % 9, blk = (o >> 6) / 9; const int row = (j & 3) + 8 * (j >> 2) + 4 * (l >> 5), c2 = blk * 32 + (l & 31);
            if (row < 17) { float sacc = F.in[5][(size_t)li * 6144 + j0 + c2];
#pragma unroll
                for (int q = 0; q < 8; ++q) sacc += red[q * (3 * 9 * 64) + o];
                WSP(float, WS_MOD)[((size_t)li * 17 + row) * 6144 + j0 + c2] = sacc; } }
        __syncthreads();
    }
}

__device__ __forceinline__ void row_norm(f32x4 (&v)[4], float eps, int lane) {
    float s = 0.f;
#pragma unroll
    for (int j = 0; j < 4; ++j) s += (v[j][0] + v[j][1]) + (v[j][2] + v[j][3]);
    const float mean = wave_sum(s, lane) * (1.f / 1024.f); float q = 0.f;
#pragma unroll
    for (int j = 0; j < 4; ++j) { v[j] = v[j] - mean; q += (v[j][0] * v[j][0] + v[j][1] * v[j][1]) + (v[j][2] * v[j][2] + v[j][3] * v[j][3]); }
    const float rstd = __builtin_amdgcn_rsqf(wave_sum(q, lane) * (1.f / 1024.f) + eps);
#pragma unroll
    for (int j = 0; j < 4; ++j) v[j] = v[j] * rstd;
}
__device__ __forceinline__ int mod_row_of(int row) { return row < NCTX ? 16 : ((row - NCTX) >> 11); }
__device__ __forceinline__ void modulate_row(f32x4 (&v)[4], const float* modrow, int so, int lane) {
    row_norm(v, 1e-6f, lane);
#pragma unroll
    for (int j = 0; j < 4; ++j) { const f32x4 sh = *(const f32x4*)(modrow + so + lane * 4 + 256 * j), sc = *(const f32x4*)(modrow + so + 1024 + lane * 4 + 256 * j); v[j] = v[j] * (sc + 1.0f) + sh; }
}
__device__ __forceinline__ void store_row_bf16(bf16_t* p, const f32x4 (&v)[4], int lane) {
#pragma unroll
    for (int j = 0; j < 4; ++j) { u32x2 w; w.x = cvt_pk_bf16(v[j][0], v[j][1]); w.y = cvt_pk_bf16(v[j][2], v[j][3]); *(u32x2*)(p + lane * 4 + 256 * j) = w; }
}
__device__ __forceinline__ void dt_rows(const f32x4 (&hA)[4], const f32x4 (&hB)[4], const LAS float* wdt, float* dtA, float* dtB, int lane) {
    float part[32];
#pragma unroll
    for (int c = 0; c < 16; ++c) { f32x4 a = {0.f, 0.f, 0.f, 0.f}, b = a;
#pragma unroll
        for (int j = 0; j < 4; ++j) { const f32x4 w = *(const LAS f32x4*)(wdt + c * 1024 + lane * 4 + 256 * j); a += hA[j] * w; b += hB[j] * w; }
        part[c] = (a[0] + a[1]) + (a[2] + a[3]); part[16 + c] = (b[0] + b[1]) + (b[2] + b[3]); if ((c & 3) == 3) __builtin_amdgcn_sched_barrier(0); }
    const float v = bfly_reduce<32>(part, lane);
    const int idx = lane >> 1;
    if ((lane & 1) == 0) { if (idx < 16) dtA[idx] = v; else dtB[idx - 16] = v; }
}
__device__ __forceinline__ void p1_rows(Frame& F) {
    int tid_ = threadIdx.x; LAUNDER_V(tid_); const int lane_ = tid_ & 63, wave_ = __builtin_amdgcn_readfirstlane(tid_ >> 6); (void)lane_; (void)wave_;
    __syncthreads();
    LAS float* wdt = (LAS float*)F.lds;
    for (int i = tid_; i < 16 * 1024 / 4; i += NTHREADS) ((LAS f32x4*)wdt)[i] = ((const f32x4*)WSP(float, WS_WDT))[i];
    __syncthreads();
    const int gw = F.bid * NWAVES + wave_, NGW = F.G * NWAVES, lane = lane_;
    const float* mod = WSP(float, WS_MOD);
    for (int rp = gw; rp < NTOK / 2; rp += NGW) {
        const int rA = rp * 2, rB = rA + 1;
        const float* srcA = rA < NCTX ? F.in[2] + (size_t)rA * 1024 : F.in[0] + (size_t)(rA - NCTX) * 1024;
        const float* srcB = rB < NCTX ? F.in[2] + (size_t)rB * 1024 : F.in[0] + (size_t)(rB - NCTX) * 1024;
        f32x4 a[4], b[4];
#pragma unroll
        for (int j = 0; j < 4; ++j) { a[j] = ((const f32x4*)srcA)[lane + 64 * j]; b[j] = ((const f32x4*)srcB)[lane + 64 * j]; }
#pragma unroll
        for (int j = 0; j < 4; ++j) { ((f32x4*)(WSP(float, WS_XL) + (size_t)rA * 1024))[lane + 64 * j] = a[j]; ((f32x4*)(WSP(float, WS_XL) + (size_t)rB * 1024))[lane + 64 * j] = b[j]; }
        modulate_row(a, mod + (size_t)mod_row_of(rA) * 6144, 0, lane);
        modulate_row(b, mod + (size_t)mod_row_of(rB) * 6144, 0, lane);
        store_row_bf16(WSP(bf16_t, WS_H) + (size_t)rA * 1024, a, lane); store_row_bf16(WSP(bf16_t, WS_H) + (size_t)rB * 1024, b, lane);
        dt_rows(a, b, wdt, WSP(float, WS_DT) + (size_t)rA * 16, WSP(float, WS_DT) + (size_t)rB * 16, lane);
    }
}
__device__ __forceinline__ void p2b_rows(Frame& F, int li, int row_lo) {
    int tid_ = threadIdx.x; LAUNDER_V(tid_); const int lane_ = tid_ & 63, wave_ = __builtin_amdgcn_readfirstlane(tid_ >> 6); (void)lane_; (void)wave_;
    LAUNDER_S(li);
    const int gw = F.bid * NWAVES + wave_, NGW = F.G * NWAVES, lane = lane_;
    const bf16_t* proj = WSP(bf16_t, WS_PROJ); bf16_t* ys = WSP(bf16_t, WS_YS);
    const float* nw = F.in[24] + (size_t)li * 512 + lane * 8;
    const f32x4 nw0 = *(const f32x4*)nw, nw1 = *(const f32x4*)(nw + 4);
    const f32x4 pb0 = *(const f32x4*)(F.in[17] + (size_t)li * 512 + lane * 8), pb1 = *(const f32x4*)(F.in[17] + (size_t)li * 512 + lane * 8 + 4);
    const f32x4 ps0 = *(const f32x4*)(F.in[18] + (size_t)li * 512 + lane * 8), ps1 = *(const f32x4*)(F.in[18] + (size_t)li * 512 + lane * 8 + 4);
    const int pwin = 2 << (lane >> 4);
    for (int row = row_lo + gw; row < NTOK; row += NGW) {
        const size_t o5 = (size_t)row * 512 + lane * 8;
        const u32x4 hfv = *(const u32x4*)(WSP(bf16_t, WS_HF) + o5), hbv = *(const u32x4*)(WSP(bf16_t, WS_HB) + o5), yfv = *(const u32x4*)(WSP(bf16_t, WS_YF) + o5), ybv = *(const u32x4*)(WSP(bf16_t, WS_YB) + o5);
        const u32x4 rgv = *(const u32x4*)(proj + (size_t)row * PW + C_RG + lane * 8), zv = *(const u32x4*)(proj + (size_t)row * PW + C_Z + lane * 8);
        {
            const int L = row < NCTX ? CTXL : SEQ, segbase = row < NCTX ? (row & ~(CTXL - 1)) : NCTX + ((row - NCTX) & ~(SEQ - 1)), t = row - segbase;
            int lo = t - pwin / 2; lo = lo < 0 ? 0 : lo; int hi = t + pwin - 1 - pwin / 2; hi = hi > L - 1 ? L - 1 : hi;
            f32x4 s0 = {0.f, 0.f, 0.f, 0.f}, s1 = s0;
            u32x4 pv[16];
#pragma unroll
            for (int j = 0; j < 16; ++j) { int tj = t - 8 + j; tj = tj < 0 ? 0 : (tj > L - 1 ? L - 1 : tj); pv[j] = *(const u32x4*)(proj + (size_t)(segbase + tj) * PW + C_PU + lane * 8); }
            asm volatile("" ::: "memory");
#pragma unroll
            for (int j = 0; j < 16; ++j) { const int tj = t - 8 + j; const float mk = (tj >= lo && tj <= hi) ? 1.0f : 0.0f; const u32x4 v = pv[j];
                s0[0] += mk * lo_bf(v.x); s0[1] += mk * hi_bf(v.x); s0[2] += mk * lo_bf(v.y); s0[3] += mk * hi_bf(v.y); s1[0] += mk * lo_bf(v.z); s1[1] += mk * hi_bf(v.z); s1[2] += mk * lo_bf(v.w); s1[3] += mk * hi_bf(v.w); }
            const u32x4 sv = *(const u32x4*)(proj + (size_t)row * PW + C_PU + lane * 8);
            const float rc = __builtin_amdgcn_rcpf((float)(hi - lo + 1));
            f32x4 m0, m1; m0[0] = s0[0] * rc - lo_bf(sv.x); m0[1] = s0[1] * rc - hi_bf(sv.x); m0[2] = s0[2] * rc - lo_bf(sv.y); m0[3] = s0[3] * rc - hi_bf(sv.y);
            m1[0] = s1[0] * rc - lo_bf(sv.z); m1[1] = s1[1] * rc - hi_bf(sv.z); m1[2] = s1[2] * rc - lo_bf(sv.w); m1[3] = s1[3] * rc - hi_bf(sv.w);
            m0 = (m0 + pb0) * ps0; m1 = (m1 + pb1) * ps1;
            u32x4 w; w.x = cvt_pk_bf16(m0[0], m0[1]); w.y = cvt_pk_bf16(m0[2], m0[3]); w.z = cvt_pk_bf16(m1[0], m1[1]); w.w = cvt_pk_bf16(m1[2], m1[3]);
            *(u32x4*)(ys + (size_t)row * 2048 + 512 + lane * 8) = w;
        }
        {
            const f32x4 y0 = bf4lo_(hfv) + bf4lo_(hbv), y1 = bf4hi_(hfv) + bf4hi_(hbv);
            const f32x4 o0 = gelu4_(bf4lo_(rgv)) * y0, o1 = gelu4_(bf4hi_(rgv)) * y1;
            u32x4 w; w.x = cvt_pk_bf16(o0[0], o0[1]); w.y = cvt_pk_bf16(o0[2], o0[3]); w.z = cvt_pk_bf16(o1[0], o1[1]); w.w = cvt_pk_bf16(o1[2], o1[3]);
            *(u32x4*)(ys + (size_t)row * 2048 + lane * 8) = w;
        }
        {
            f32x4 g0 = (bf4lo_(yfv) + bf4lo_(ybv)) * silu4_(bf4lo_(zv)), g1 = (bf4hi_(yfv) + bf4hi_(ybv)) * silu4_(bf4hi_(zv));
            float ss = (g0[0] * g0[0] + g0[1] * g0[1]) + (g0[2] * g0[2] + g0[3] * g0[3]) + (g1[0] * g1[0] + g1[1] * g1[1]) + (g1[2] * g1[2] + g1[3] * g1[3]);
#pragma unroll
            for (int o = 1; o < 32; o <<= 1) ss += shx(ss, o, lane);
            const float r = __builtin_amdgcn_rsqf(ss * (1.f / 256.f) + 1e-5f);
            g0 = g0 * r * nw0; g1 = g1 * r * nw1;
            u32x4 w; w.x = cvt_pk_bf16(g0[0], g0[1]); w.y = cvt_pk_bf16(g0[2], g0[3]); w.z = cvt_pk_bf16(g1[0], g1[1]); w.w = cvt_pk_bf16(g1[2], g1[3]);
            *(u32x4*)(ys + (size_t)row * 2048 + 1536 + lane * 8) = w;
        }
    }
}
__device__ __forceinline__ void p5_rows(Frame& F, int li, int row_lo, bool dry) {
    int tid_ = threadIdx.x; LAUNDER_V(tid_); const int lane_ = tid_ & 63, wave_ = __builtin_amdgcn_readfirstlane(tid_ >> 6); (void)lane_; (void)wave_;
    LAUNDER_S(li);
    __syncthreads();
    LAS float* rw = (LAS float*)F.lds;
    LAS unsigned* hist = (LAS unsigned*)(F.lds + XTRA_OFF);
    LAS unsigned* basev = hist + 32;
    LAS unsigned* ent = hist + 64;
#pragma unroll 16
    for (int i = tid_; i < 32 * 1024 / 4; i += NTHREADS) ((LAS f32x4*)rw)[i] = ((const f32x4*)(WSP(float, WS_ROUT) + (size_t)li * 32 * 1024))[i];
    if (tid_ < 32) hist[tid_] = 0u;
    const int lane = lane_;
    const int nrows = NTOK - row_lo, per = (nrows / 2 + F.G - 1) / F.G;
    const int p_lo = F.bid * per, p_hi = (p_lo + per) < (nrows / 2) ? (p_lo + per) : (nrows / 2);
    const float* mod = WSP(float, WS_MOD) + (size_t)li * 17 * 6144;
    const float rb = F.in[32][li * 32 + (lane & 31)];
    unsigned* ecnt = WSP(unsigned, WS_CTL) + CW_ECNT + li * 32 * 64;
    LAS float* lgs = (LAS float*)(F.lds + XTRA_OFF + 4864);
    LAS float* mds = (LAS float*)(F.lds + XTRA2_OFF);
    const int mA = mod_row_of(row_lo + p_lo * 2) > 16 ? 16 : mod_row_of(row_lo + p_lo * 2), mB = mod_row_of(row_lo + (p_hi > p_lo ? p_hi * 2 - 1 : p_lo * 2)) > 16 ? 16 : mod_row_of(row_lo + (p_hi > p_lo ? p_hi * 2 - 1 : p_lo * 2));
    {   const int q = tid_ & 255; const float* src = (tid_ >> 8) ? F.in[28] + (size_t)li * 1024 : F.in[27] + (size_t)li * 1024;
        ((LAS f32x4*)lgs)[tid_] = ((const f32x4*)src)[q];
#pragma unroll
        for (int i = 0; i < 2; ++i) { const int idx = tid_ + 512 * i, sl = idx >> 9, q9 = idx & 511;
            ((LAS f32x4*)mds)[idx] = ((const f32x4*)(mod + (size_t)(sl ? mB : mA) * 6144 + 3072))[q9]; } }
    __syncthreads();
    const float* xl = WSP(float, WS_XL); const bf16_t* yb = WSP(bf16_t, WS_MACC);
    f32x4 ca[4], cb[4], na[4], nb[4]; u32x2 cya[4], cyb[4], nya[4], nyb[4];
#define P5_ISSUE(A_, B_, YA_, YB_, RP_) do { const int rA_ = row_lo + (RP_) * 2; _Pragma("unroll") for (int j = 0; j < 4; ++j) { A_[j] = ((const f32x4*)(xl + (size_t)rA_ * 1024))[lane + 64 * j]; B_[j] = ((const f32x4*)(xl + (size_t)(rA_ + 1) * 1024))[lane + 64 * j]; } \
        _Pragma("unroll") for (int j = 0; j < 4; ++j) { YA_[j] = *(const u32x2*)(yb + (size_t)rA_ * 1024 + lane * 4 + 256 * j); YB_[j] = *(const u32x2*)(yb + (size_t)(rA_ + 1) * 1024 + lane * 4 + 256 * j); } } while (0)
    int rp = p_lo + wave_;
    if (rp < p_hi) P5_ISSUE(ca, cb, cya, cyb, rp);
    for (; rp < p_hi; rp += NWAVES) {
        const int rA = row_lo + rp * 2, rB = rA + 1;
        float* xAo = (dry ? WSP(float, WS_HF) : WSP(float, WS_XL)) + (size_t)rA * 1024; float* xBo = (dry ? WSP(float, WS_HF) : WSP(float, WS_XL)) + (size_t)rB * 1024;
        bf16_t* hO = dry ? WSP(bf16_t, WS_XG) : WSP(bf16_t, WS_H);
        { const int rn = rp + NWAVES; const int rq = rn < p_hi ? rn : rp; P5_ISSUE(na, nb, nya, nyb, rq); }
        asm volatile("" ::: "memory");
        const LAS float* ms = mds + ((mod_row_of(rA) == mA) ? 0 : 2048);
        f32x4 a[4], b[4];
#pragma unroll
        for (int j = 0; j < 4; ++j) {
            const u32x2 ya = cya[j], yb2 = cyb[j];
            a[j] = ca[j] * DN_ALPHA + (f32x4){lo_bf(ya.x), hi_bf(ya.x), lo_bf(ya.y), hi_bf(ya.y)}; b[j] = cb[j] * DN_ALPHA + (f32x4){lo_bf(yb2.x), hi_bf(yb2.x), lo_bf(yb2.y), hi_bf(yb2.y)}; }
        row_norm(a, 1e-5f, lane); row_norm(b, 1e-5f, lane);
#pragma unroll
        for (int j = 0; j < 4; ++j) { const f32x4 g = *(const LAS f32x4*)(lgs + lane * 4 + 256 * j), bb = *(const LAS f32x4*)(lgs + 1024 + lane * 4 + 256 * j); a[j] = a[j] * g + bb; b[j] = b[j] * g + bb;
            ((f32x4*)xAo)[lane + 64 * j] = a[j]; ((f32x4*)xBo)[lane + 64 * j] = b[j]; }
        row_norm(a, 1e-6f, lane); row_norm(b, 1e-6f, lane);
#pragma unroll
        for (int j = 0; j < 4; ++j) { const f32x4 sh = *(const LAS f32x4*)(ms + lane * 4 + 256 * j), sc = *(const LAS f32x4*)(ms + 1024 + lane * 4 + 256 * j); a[j] = a[j] * (sc + 1.0f) + sh; b[j] = b[j] * (sc + 1.0f) + sh; }
        store_row_bf16(hO + (size_t)rA * 1024, a, lane); store_row_bf16(hO + (size_t)rB * 1024, b, lane);
#pragma unroll
        for (int j = 0; j < 4; ++j) { ca[j] = na[j]; cb[j] = nb[j]; cya[j] = nya[j]; cyb[j] = nyb[j]; }
        float res[2];
#pragma unroll
        for (int hf = 0; hf < 2; ++hf) {
            float part[32];
#pragma unroll
            for (int e = 0; e < 16; ++e) { f32x4 sa = {0.f, 0.f, 0.f, 0.f}, sb = sa;
#pragma unroll
                for (int j = 0; j < 4; ++j) { const f32x4 w = *(const LAS f32x4*)(rw + (hf * 16 + e) * 1024 + lane * 4 + 256 * j); sa += a[j] * w; sb += b[j] * w; }
                part[e] = (sa[0] + sa[1]) + (sa[2] + sa[3]); part[16 + e] = (sb[0] + sb[1]) + (sb[2] + sb[3]); if ((e & 3) == 3) __builtin_amdgcn_sched_barrier(0); }
            res[hf] = bfly_reduce<32>(part, lane);
            __builtin_amdgcn_sched_barrier(0);
        }
        const int srcl = (lane & 32) | ((lane & 15) << 1);
        const float r0 = shl_(res[0], srcl), r1 = shl_(res[1], srcl);
        float lv = ((lane & 16) ? r1 : r0) + rb;
        float selv[4]; int sele[4];
#pragma unroll
        for (int k = 0; k < 4; ++k) {
            float m = lv; int mi = lane & 31;
#pragma unroll
            for (int o = 16; o >= 1; o >>= 1) { const float om = shx(m, o, lane); const int oi = shxi(mi, o, lane); if (om > m || (om == m && oi < mi)) { m = om; mi = oi; } }
            selv[k] = m; sele[k] = mi; if ((lane & 31) == mi) lv = -INFINITY;
        }
        const float e1 = __expf(selv[1] - selv[0]), e2 = __expf(selv[2] - selv[0]), e3 = __expf(selv[3] - selv[0]); const float inv = __builtin_amdgcn_rcpf(1.0f + e1 + e2 + e3);
        const int k = lane & 31;
        if (k < 4) {
            const int row = (lane >> 5) ? rB : rA;
            const float pk = (k == 0 ? 1.0f : k == 1 ? e1 : k == 2 ? e2 : e3) * inv; const int ek = (k == 0 ? sele[0] : k == 1 ? sele[1] : k == 2 ? sele[2] : sele[3]);
            if (!dry) WSP(float, WS_EP)[(size_t)row * 4 + k] = pk;
            const unsigned lp = __hip_atomic_fetch_add(&hist[ek], 1u, __ATOMIC_RELAXED, __HIP_MEMORY_SCOPE_WORKGROUP);
            const int n = ((rp - p_lo) * 2 + (lane >> 5)) * 4 + k;
            ent[n * 2] = (unsigned)(row * 4 + k); ent[n * 2 + 1] = (unsigned)ek | (lp << 8);
        }
    }
    __syncthreads();
    if (dry) return;
    if (tid_ < 32) basev[tid_] = atomicAdd(&ecnt[tid_ * 64], hist[tid_]);
    __syncthreads();
    const int nent = (p_hi > p_lo ? (p_hi - p_lo) : 0) * 8;
    int* elist = WSP(int, WS_ELIST);
    for (int n = tid_; n < nent; n += NTHREADS) { const unsigned t4 = ent[n * 2], w = ent[n * 2 + 1]; const unsigned e = w & 255u, lp = w >> 8; elist[(size_t)e * ECAP + basev[e] + lp] = (int)t4; }
}
__device__ __forceinline__ void moe_tstart(Frame& F, int li, LAS int* tstart) {
    __syncthreads();
    int tid = threadIdx.x; LAUNDER_V(tid); LAUNDER_S(li);
    if (tid < 32) {
        const unsigned* ecnt = WSP(unsigned, WS_CTL) + CW_ECNT + li * 32 * 64;
        const int lane = tid;
        const int nt = ((int)__hip_atomic_load(ecnt + lane * 64, __ATOMIC_RELAXED, __HIP_MEMORY_SCOPE_AGENT) + 255) >> 8;
        int incl = nt;
#pragma unroll
        for (int o = 1; o < 32; o <<= 1) { const int t = __builtin_amdgcn_ds_bpermute(((lane - o) & 63) << 2, incl); incl += (lane >= o) ? t : 0; }
        tstart[lane] = incl - nt;
        if (lane == 31) tstart[32] = incl;
    }
    __syncthreads();
}
__device__ __forceinline__ void moe_toks(Frame& F, int li, const LAS int* tstart, LAS unsigned short* toks, int nN) {
    const unsigned* ecnt = WSP(unsigned, WS_CTL) + CW_ECNT + li * 32 * 64; const int* elist = WSP(int, WS_ELIST);
    int tid = threadIdx.x; LAUNDER_V(tid); LAUNDER_S(li);
    const int total = tstart[32];
    int tk[14]; int nu = 0;
#pragma unroll
    for (int j = 0; j < 14; ++j) {
        const int i = (tid >> 8) + 2 * j; int mtg, pn; tk[j] = 0;
        if (moe_unit(i, F.bid, F.G, nN, total, mtg, pn)) {
            int e = 0;
            for (int k = 1; k < 32; ++k) e += (tstart[k] <= mtg) ? 1 : 0;
            const int pos = (mtg - tstart[e]) * 256 + (tid & 255);
            const int cnt = ((tstart[e + 1] - tstart[e] - 1) == (mtg - tstart[e])) ? (int)ecnt[e * 64] : 0x7fffffff;
            tk[j] = elist[(size_t)e * ECAP + (pos < cnt ? pos : 0)] | (pos < cnt ? 0 : (int)0x80000000);
            nu = j + 1;
        }
    }
#pragma unroll
    for (int j = 0; j < 14; ++j) if (j < nu) { const int i = (tid >> 8) + 2 * j; toks[i * 256 + (tid & 255)] = (unsigned short)(tk[j] < 0 ? 0 : (tk[j] >> 2)); }
    __syncthreads();
}
struct P9Ld { unsigned yw[2][4][4]; f32x4 xv[2][4]; f32x4 pkv[2]; };
__device__ __forceinline__ void p9_issue(P9Ld& L, const unsigned char* y2, const float* xl, const float* ep, int rp, int lane) {
#pragma unroll
    for (int h = 0; h < 2; ++h) { const int row = rp * 2 + h; L.pkv[h] = *(const f32x4*)(ep + (size_t)row * 4);
#pragma unroll
        for (int j = 0; j < 4; ++j) { L.xv[h][j] = ((const f32x4*)(xl + (size_t)row * 1024))[lane + 64 * j];
#pragma unroll
            for (int k = 0; k < 4; ++k) L.yw[h][j][k] = *(const unsigned*)(y2 + ((size_t)row * 4 + k) * 1024 + lane * 4 + 256 * j); } }
}
__device__ __forceinline__ void p9_rows(Frame& F, int li, int row_lo, bool dry) {
    int tid_ = threadIdx.x; LAUNDER_V(tid_); const int lane_ = tid_ & 63, wave_ = __builtin_amdgcn_readfirstlane(tid_ >> 6); (void)lane_; (void)wave_;
    LAUNDER_S(li);
    __syncthreads();
    const bool lastl = (li == DEPTH - 1);
    LAS float* wdt = (LAS float*)F.lds;
    LAS float* lgs = (LAS float*)(F.lds + 65536);
    LAS float* mds = (LAS float*)(F.lds + 65536 + 8192);
    const int nrows = NTOK - row_lo, per = (nrows / 2 + F.G - 1) / F.G;
    const int p_lo = row_lo / 2 + F.bid * per, p_hi = (p_lo + per) < (NTOK / 2) ? (p_lo + per) : (NTOK / 2);
    const int mA = mod_row_of(p_lo * 2), mB = mod_row_of(p_hi > p_lo ? p_hi * 2 - 1 : p_lo * 2);
    const float* mod = WSP(float, WS_MOD) + (size_t)li * 17 * 6144;
    const float* modn = WSP(float, WS_MOD) + (size_t)(lastl ? li : li + 1) * 17 * 6144;
    if (!lastl) {
#pragma unroll 8
        for (int i = tid_; i < 16 * 1024 / 4; i += NTHREADS) ((LAS f32x4*)wdt)[i] = ((const f32x4*)(WSP(float, WS_WDT) + (size_t)(li + 1) * 16 * 1024))[i]; }
    {   const int q = tid_ & 255; const float* src = (tid_ >> 8) ? F.in[30] + (size_t)li * 1024 : F.in[29] + (size_t)li * 1024;
        ((LAS f32x4*)lgs)[tid_] = ((const f32x4*)src)[q];
#pragma unroll
        for (int i = 0; i < 3; ++i) { const int idx = tid_ + 512 * i, sl = idx / 768, c = (idx % 768) >> 8, q4 = idx & 255; const int mr = sl ? mB : mA;
            const float* sp = (c == 0) ? mod + (size_t)mr * 6144 + 5120 : modn + (size_t)mr * 6144 + (c - 1) * 1024;
            ((LAS f32x4*)mds)[idx] = ((const f32x4*)sp)[q4]; } }
    __syncthreads();
    const int lane = lane_;
    const unsigned char* y2 = WSP(unsigned char, WS_Y2);
    const float* xl = WSP(float, WS_XL); const float* ep = WSP(float, WS_EP);
    P9Ld cur, nxt;
    int rp = p_lo + wave_;
    if (rp < p_hi) p9_issue(cur, y2, xl, ep, rp, lane);
    for (; rp < p_hi; rp += NWAVES) {
        { const int rn = rp + NWAVES; p9_issue(nxt, y2, xl, ep, rn < p_hi ? rn : rp, lane); }
        asm volatile("" ::: "memory");
        const LAS float* ms = mds + ((mod_row_of(rp * 2) == mA) ? 0 : 3 * 1024);
        f32x4 v[2][4];
#pragma unroll
        for (int h = 0; h < 2; ++h) {
#pragma unroll
            for (int j = 0; j < 4; ++j) { f32x4 f = {0.f, 0.f, 0.f, 0.f};
#pragma unroll
                for (int k = 0; k < 4; ++k) { const int w = (int)cur.yw[h][j][k]; const float pk = cur.pkv[h][k]; const f32x2 lo2 = __builtin_amdgcn_cvt_pk_f32_fp8(w, false), hi2 = __builtin_amdgcn_cvt_pk_f32_fp8(w, true);
                    f += (f32x4){lo2[0], lo2[1], hi2[0], hi2[1]} * pk; }
                const f32x4 g = *(const LAS f32x4*)(ms + lane * 4 + 256 * j);
                v[h][j] = cur.xv[h][j] * DN_ALPHA + g * f; } }
#pragma unroll
        for (int h = 0; h < 2; ++h) {
            const int row = rp * 2 + h;
            float* xw = (dry ? WSP(float, WS_HF) : WSP(float, WS_XL)) + (size_t)row * 1024;
            row_norm(v[h], 1e-5f, lane);
#pragma unroll
            for (int j = 0; j < 4; ++j) { const f32x4 g = *(const LAS f32x4*)(lgs + lane * 4 + 256 * j), bb = *(const LAS f32x4*)(lgs + 1024 + lane * 4 + 256 * j); v[h][j] = v[h][j] * g + bb; }
            if (lastl) {
#pragma unroll
                for (int j = 0; j < 4; ++j) ((f32x4*)((dry ? WSP(float, WS_HF) : F.out) + (size_t)(row - NCTX) * 1024))[lane + 64 * j] = v[h][j];
            } else {
#pragma unroll
                for (int j = 0; j < 4; ++j) ((f32x4*)xw)[lane + 64 * j] = v[h][j];
                row_norm(v[h], 1e-6f, lane);
#pragma unroll
                for (int j = 0; j < 4; ++j) { const f32x4 sh = *(const LAS f32x4*)(ms + 1024 + lane * 4 + 256 * j), sc = *(const LAS f32x4*)(ms + 2048 + lane * 4 + 256 * j); v[h][j] = v[h][j] * (sc + 1.0f) + sh; }
                store_row_bf16((dry ? WSP(bf16_t, WS_XG) : WSP(bf16_t, WS_H)) + (size_t)row * 1024, v[h], lane);
            }
        }
        if (!lastl) { float* dto = dry ? WSP(float, WS_YF) : WSP(float, WS_DT); dt_rows(v[0], v[1], wdt, dto + (size_t)(rp * 2) * 16, dto + (size_t)(rp * 2 + 1) * 16, lane); }
        cur = nxt;
    }
}

__device__ __forceinline__ void ssd_unit2(Frame& F, int li, int b, int hp, int dir, bool ctx_out) {
    constexpr int P72 = 72;
    constexpr int RP = 264;
    LAS bf16_t* RAW = (LAS bf16_t*)F.lds;
    LAS bf16_t* BN = (LAS bf16_t*)(F.lds + 35968);
    LAS bf16_t* CN = BN + 64 * P72;
    LAS bf16_t* BT = CN + 64 * P72;
    LAS bf16_t* XT = BT + 64 * P72;
    LAS bf16_t* XDT = XT + 2 * 64 * P72;
    LAS bf16_t* HS = XDT + 2 * 64 * P72;
    LAS float* CUM = (LAS float*)(HS + 2 * 64 * P72);
    LAS float* DTS = CUM + 128; LAS float* RDT = DTS + 128; LAS float* ED = RDT + 128; LAS float* TOT = ED + 128;
    LAS float* CW = TOT + 8;
    int tid = threadIdx.x; LAUNDER_V(tid); LAUNDER_S(li);
    const int lane = tid & 63, w = __builtin_amdgcn_readfirstlane(tid >> 6), r32 = lane & 31, hh = lane >> 5;
    const int hsel = w >> 2, pt = (w >> 1) & 1, lt = w & 1, g = hp >> 1;
    const int hd = hp * 2 + hsel;
    const bf16_t* proj = WSP(bf16_t, WS_PROJ); const float* dtp = WSP(float, WS_DT);
    bf16_t* yd = dir ? WSP(bf16_t, WS_YB) : WSP(bf16_t, WS_YF);
    __syncthreads();
    for (int i = tid; i < 5 * 256; i += NTHREADS) { const int k = i >> 8, ch = i & 255; const int gc = ch < 128 ? hp * 128 + ch : (ch < 192 ? 512 + g * 64 + (ch - 128) : 640 + g * 64 + (ch - 192));
        CW[i] = k < 4 ? F.in[19][((size_t)li * 4 + k) * 768 + gc] : F.in[20][(size_t)li * 768 + gc]; }
    for (int i = tid; i < 2 * 64 * P72 / 2; i += NTHREADS) ((LAS unsigned*)HS)[i] = 0u;
    const float av = -__expf(F.in[22][(li * 2 + dir) * 8 + hd]) * 1.4426950408889634f, dtb = F.in[21][(li * 2 + dir) * 8 + hd], dsk = F.in[23][(li * 2 + dir) * 8 + hd];
    const int g8 = tid & 31;
    const int rcol = g8 < 16 ? C_XBC + hp * 128 + g8 * 8 : (g8 < 24 ? C_XBC + 512 + g * 64 + (g8 - 16) * 8 : C_XBC + 640 + g * 64 + (g8 - 24) * 8);
    f32x16 Hreg = (f32x16){};
    u32x4 pre[5]; float predt = 0.f;
    auto chunk_pos = [&](int c, int& L, int& rowbase, int& t0) { const int seg = c >= 4, ci = seg ? c - 4 : c; L = seg ? SEQ : CTXL; rowbase = seg ? NCTX + b * SEQ : b * CTXL; const int nch = L / 64; t0 = (dir ? nch - 1 - ci : ci) * 64; };
    auto prefetch = [&](int c) {
        int L, rowbase, t0; chunk_pos(c, L, rowbase, t0);
#pragma unroll
        for (int i = 0; i < 5; ++i) { const int idx = tid + 512 * i; const int r = idx >> 5; int tr = t0 - 2 + r; tr = tr < 0 ? 0 : (tr > L - 1 ? L - 1 : tr);
            pre[i] = *(const u32x4*)(proj + (size_t)(rowbase + tr) * PW + rcol); }
        if ((w & 3) == 0) predt = dtp[(size_t)(rowbase + t0 + lane) * 16 + dir * 8 + hd];
    };
    prefetch(0);
#pragma unroll 1
    for (int c = 0; c < 36; ++c) {
        int L, rowbase, t0; chunk_pos(c, L, rowbase, t0);
#pragma unroll
        for (int i = 0; i < 5; ++i) { const int idx = tid + 512 * i; const int r = idx >> 5, tr = t0 - 2 + r; u32x4 v = pre[i]; if (tr < 0 || tr >= L) v = (u32x4){0u, 0u, 0u, 0u};
            if (idx < 68 * 32) *(LAS u32x4*)(RAW + r * RP + g8 * 8) = v; }
        if ((w & 3) == 0) {
            const float dt = softplusf_(predt + dtb); const float a = dt * av;
            float cs = a;
#pragma unroll
            for (int o = 1; o < 64; o <<= 1) { const int src = dir ? lane + o : lane - o; const float t = shl_(cs, src & 63); const bool ok = dir ? (lane + o < 64) : (lane >= o); cs += ok ? t : 0.f; }
            const float cend = shl_(cs, dir ? 0 : 63);
            CUM[hsel * 64 + lane] = cs; DTS[hsel * 64 + lane] = dt; RDT[hsel * 64 + lane] = 1.0f / dt; ED[hsel * 64 + lane] = exp2f(cend - cs);
            if (lane == 0) TOT[hsel] = exp2f(cend);
        }
        {
            LAS bf16_t* hq = HS + hsel * 64 * P72 + 32 * lt + r32;
#pragma unroll
            for (int r = 0; r < 16; ++r) hq[(32 * pt + (r & 3) + 8 * (r >> 2) + 4 * hh) * P72] = f2bf(Hreg[r]);
        }
        LDS_BARRIER();
        if (c + 1 < 36) prefetch(c + 1);
#pragma unroll
        for (int i = 0; i < 4; ++i) {
            const int tt = lane, gs = w + 8 * i;
            f32x4 a0 = *(const LAS f32x4*)(CW + 4 * 256 + gs * 8), a1 = *(const LAS f32x4*)(CW + 4 * 256 + gs * 8 + 4);
#pragma unroll
            for (int k = 0; k < 4; ++k) { const u32x4 rv = *(const LAS u32x4*)(RAW + (tt + k) * RP + gs * 8); const f32x4 w0 = *(const LAS f32x4*)(CW + k * 256 + gs * 8), w1 = *(const LAS f32x4*)(CW + k * 256 + gs * 8 + 4);
                a0[0] += w0[0] * lo_bf(rv.x); a0[1] += w0[1] * hi_bf(rv.x); a0[2] += w0[2] * lo_bf(rv.y); a0[3] += w0[3] * hi_bf(rv.y);
                a1[0] += w1[0] * lo_bf(rv.z); a1[1] += w1[1] * hi_bf(rv.z); a1[2] += w1[2] * lo_bf(rv.w); a1[3] += w1[3] * hi_bf(rv.w); }
            float u[8];
#pragma unroll
            for (int j = 0; j < 4; ++j) { u[j] = a0[j] * __builtin_amdgcn_rcpf(1.0f + __builtin_amdgcn_exp2f(-1.4426950408889634f * a0[j])); u[4 + j] = a1[j] * __builtin_amdgcn_rcpf(1.0f + __builtin_amdgcn_exp2f(-1.4426950408889634f * a1[j])); }
            if (gs < 16) {
                const int hs2 = gs >> 3; const float dtv = DTS[hs2 * 64 + tt], edv = ED[hs2 * 64 + tt];
                LAS bf16_t* xp = XT + (hs2 * 64 + (gs & 7) * 8) * P72 + tt; LAS bf16_t* xdp = XDT + (hs2 * 64 + (gs & 7) * 8) * P72 + tt;
#pragma unroll
                for (int j = 0; j < 8; ++j) { const float x = u[j] * dtv; xp[j * P72] = f2bf(x); xdp[j * P72] = f2bf(x * edv); }
            } else {
                u32x4 pk; pk.x = cvt_pk_bf16(u[0], u[1]); pk.y = cvt_pk_bf16(u[2], u[3]); pk.z = cvt_pk_bf16(u[4], u[5]); pk.w = cvt_pk_bf16(u[6], u[7]);
                if (gs < 24) { const int n0 = (gs - 16) * 8; *(LAS u32x4*)(BN + tt * P72 + n0) = pk;
#pragma unroll
                    for (int j = 0; j < 8; ++j) BT[(n0 + j) * P72 + tt] = f2bf(u[j]);
                } else { const int n0 = (gs - 24) * 8; *(LAS u32x4*)(CN + tt * P72 + n0) = pk; }
            }
        }
        LDS_BARRIER();
        {
            const int l = 32 * lt + r32;
            const float cl = CUM[hsel * 64 + l];
            bf16x8 cfr[4];
#pragma unroll
            for (int ks = 0; ks < 4; ++ks) cfr[ks] = *(const LAS bf16x8*)(CN + l * P72 + 16 * ks + 8 * hh);
            f32x16 acc2 = (f32x16){};
#pragma unroll
            for (int ks = 0; ks < 4; ++ks) { const bf16x8 hf = *(const LAS bf16x8*)(HS + (hsel * 64 + 32 * pt + r32) * P72 + 16 * ks + 8 * hh); acc2 = __builtin_amdgcn_mfma_f32_32x32x16_bf16(hf, cfr[ks], acc2, 0, 0, 0); }
            f32x16 acc1 = (f32x16){};
#pragma unroll
            for (int st = 0; st < 2; ++st) {
                const bool need = dir ? (st >= lt) : (st <= lt);
                if (need) {
                    f32x16 gt = (f32x16){};
#pragma unroll
                    for (int ks = 0; ks < 4; ++ks) { const bf16x8 bf = *(const LAS bf16x8*)(BN + (32 * st + r32) * P72 + 16 * ks + 8 * hh); gt = __builtin_amdgcn_mfma_f32_32x32x16_bf16(bf, cfr[ks], gt, 0, 0, 0); }
                    const float diag = dsk * RDT[hsel * 64 + l];
#pragma unroll
                    for (int r4 = 0; r4 < 4; ++r4) { const f32x4 csv = *(const LAS f32x4*)(CUM + hsel * 64 + 32 * st + 8 * r4 + 4 * hh);
#pragma unroll
                        for (int q = 0; q < 4; ++q) { const int sidx = 32 * st + 8 * r4 + 4 * hh + q; const float d = fminf(cl - csv[q], 0.f); const bool valid = dir ? (sidx >= l) : (sidx <= l);
                            float wv = valid ? gt[4 * r4 + q] * __builtin_amdgcn_exp2f(d) : 0.f; if (sidx == l) wv += diag; gt[4 * r4 + q] = wv; } }
#pragma unroll
                    for (int k2 = 0; k2 < 2; ++k2) {
                        u32x4 pw; pw.x = cvt_pk_bf16(gt[8 * k2 + 0], gt[8 * k2 + 1]); pw.y = cvt_pk_bf16(gt[8 * k2 + 2], gt[8 * k2 + 3]); pw.z = cvt_pk_bf16(gt[8 * k2 + 4], gt[8 * k2 + 5]); pw.w = cvt_pk_bf16(gt[8 * k2 + 6], gt[8 * k2 + 7]);
                        const LAS bf16_t* xq = XT + (hsel * 64 + 32 * pt + r32) * P72 + 32 * st + 16 * k2 + 4 * hh;
                        const u32x2 x0 = *(const LAS u32x2*)xq, x1 = *(const LAS u32x2*)(xq + 8);
                        const u32x4 xa = {x0.x, x0.y, x1.x, x1.y};
                        acc1 = __builtin_amdgcn_mfma_f32_32x32x16_bf16(__builtin_bit_cast(bf16x8, xa), __builtin_bit_cast(bf16x8, pw), acc1, 0, 0, 0);
                    }
                }
            }
            const float ecl = __builtin_amdgcn_exp2f(cl);
            if (c >= 4 || ctx_out) {
                bf16_t* yrow = yd + (size_t)(rowbase + t0 + l) * 512 + hd * 64 + 32 * pt + 4 * hh;
#pragma unroll
                for (int r4 = 0; r4 < 4; ++r4) { f32x4 o;
#pragma unroll
                    for (int q = 0; q < 4; ++q) o[q] = acc1[4 * r4 + q] + ecl * acc2[4 * r4 + q];
                    u32x2 ow; ow.x = cvt_pk_bf16(o[0], o[1]); ow.y = cvt_pk_bf16(o[2], o[3]); *(u32x2*)(yrow + 8 * r4) = ow; }
            }
            f32x16 acc3 = (f32x16){};
#pragma unroll
            for (int ks = 0; ks < 4; ++ks) { const bf16x8 xf = *(const LAS bf16x8*)(XDT + (hsel * 64 + 32 * pt + r32) * P72 + 16 * ks + 8 * hh); const bf16x8 bf = *(const LAS bf16x8*)(BT + (32 * lt + r32) * P72 + 16 * ks + 8 * hh);
                acc3 = __builtin_amdgcn_mfma_f32_32x32x16_bf16(xf, bf, acc3, 0, 0, 0); }
            const float tot = TOT[hsel];
#pragma unroll
            for (int r = 0; r < 16; ++r) Hreg[r] = tot * Hreg[r] + acc3[r];
        }
        LDS_BARRIER();
    }
}
__device__ __forceinline__ void rglru_unit(Frame& F, int li, int b, int blk, int dir, bool ctx_out) {
    LAS bf16_t* raw = (LAS bf16_t*)F.lds;
    constexpr int FP = 68;
    LAS float* u_s = (LAS float*)(F.lds + 8704);
    LAS bf16_t* ub_s = (LAS bf16_t*)(F.lds + 8704 + 17408);
    LAS float* a_s = (LAS float*)(F.lds + 8704 + 17408 + 9216);
    LAS float* b_s = a_s + 64 * FP; LAS float* h_s = b_s + 64 * FP; LAS float* sg_s = h_s + 64 * FP;
    int tid = threadIdx.x; LAUNDER_V(tid); LAUNDER_S(li);
    const int lane = tid & 63, w = __builtin_amdgcn_readfirstlane(tid >> 6), mt = w & 3, ntp = w >> 2;
    const bf16_t* proj = WSP(bf16_t, WS_PROJ);
    bf16_t* hd_ = dir ? WSP(bf16_t, WS_HB) : WSP(bf16_t, WS_HF);
    __syncthreads();
    f32x4 cwr[5][2];
#pragma unroll
    for (int k = 0; k < 5; ++k) { const float* cp = k < 4 ? F.in[7] + ((size_t)li * 4 + k) * 512 + blk * 64 + (tid & 7) * 8 : F.in[8] + (size_t)li * 512 + blk * 64 + (tid & 7) * 8; cwr[k][0] = *(const f32x4*)cp; cwr[k][1] = *(const f32x4*)(cp + 4); }
    bf16x8 Wf[2][2][2];
    f32x4 ba4[2], bx4[2], nl4[2];
#pragma unroll
    for (int ntl = 0; ntl < 2; ++ntl) {
        const int nt = ntp * 2 + ntl;
#pragma unroll
        for (int gate = 0; gate < 2; ++gate)
#pragma unroll
            for (int ks = 0; ks < 2; ++ks)
                Wf[gate][ntl][ks] = *(const bf16x8*)(WSP(bf16_t, WS_RNNW) + ((((size_t)(li * 2 + dir) * 2 + gate) * 8 + blk) * 64 + 16 * nt + (lane & 15)) * 64 + 32 * ks + 8 * (lane >> 4));
        const int ch = blk * 64 + 16 * nt + 4 * (lane >> 4);
        ba4[ntl] = *(const f32x4*)(F.in[10] + (size_t)(li * 2 + dir) * 512 + ch); bx4[ntl] = *(const f32x4*)(F.in[12] + (size_t)(li * 2 + dir) * 512 + ch);
        const f32x4 lm = *(const f32x4*)(F.in[13] + (size_t)(li * 2 + dir) * 512 + ch);
#pragma unroll
        for (int r = 0; r < 4; ++r) nl4[ntl][r] = -8.0f * softplusf_(-lm[r]);
    }
    float h = 0.f;
    u32x4 pre[2];
    auto chunk_pos = [&](int c, int& L, int& rowbase, int& t0) { const int seg = c >= 4, ci = seg ? c - 4 : c; L = seg ? SEQ : CTXL; rowbase = seg ? NCTX + b * SEQ : b * CTXL; const int nch = L / 64; t0 = (dir ? nch - 1 - ci : ci) * 64; };
    auto prefetch = [&](int c) { int L, rowbase, t0; chunk_pos(c, L, rowbase, t0);
#pragma unroll
        for (int i = 0; i < 2; ++i) { const int idx = tid + 512 * i; int tr = t0 - 2 + (idx >> 3); tr = tr < 0 ? 0 : (tr > L - 1 ? L - 1 : tr);
            pre[i] = *(const u32x4*)(proj + (size_t)(rowbase + tr) * PW + C_RX + blk * 64 + (idx & 7) * 8); } };
    prefetch(0);
    {
#pragma unroll 1
        for (int c = 0; c < 36; ++c) {
            int L, rowbase, t0; chunk_pos(c, L, rowbase, t0); const int seg = c >= 4;
            LDS_BARRIER();
#pragma unroll
            for (int i = 0; i < 2; ++i) { const int idx = tid + 512 * i; const int r = idx >> 3, tr = t0 - 2 + r; u32x4 v = pre[i]; if (tr < 0 || tr >= L) v = (u32x4){0u, 0u, 0u, 0u};
                if (idx < 67 * 8) *(LAS u32x4*)(raw + r * 64 + (idx & 7) * 8) = v; }
            LDS_BARRIER();
            if (c + 1 < 36) prefetch(c + 1);
            {   const int tt = tid >> 3, c8 = tid & 7;
                f32x4 a0 = cwr[4][0], a1 = cwr[4][1];
#pragma unroll
                for (int k = 0; k < 4; ++k) { const u32x4 rv = *(const LAS u32x4*)(raw + (tt + k) * 64 + c8 * 8);
                    a0[0] += cwr[k][0][0] * lo_bf(rv.x); a0[1] += cwr[k][0][1] * hi_bf(rv.x); a0[2] += cwr[k][0][2] * lo_bf(rv.y); a0[3] += cwr[k][0][3] * hi_bf(rv.y);
                    a1[0] += cwr[k][1][0] * lo_bf(rv.z); a1[1] += cwr[k][1][1] * hi_bf(rv.z); a1[2] += cwr[k][1][2] * lo_bf(rv.w); a1[3] += cwr[k][1][3] * hi_bf(rv.w); }
                *(LAS f32x4*)(u_s + tt * FP + c8 * 8) = a0; *(LAS f32x4*)(u_s + tt * FP + c8 * 8 + 4) = a1;
                u32x4 pk; pk.x = cvt_pk_bf16(a0[0], a0[1]); pk.y = cvt_pk_bf16(a0[2], a0[3]); pk.z = cvt_pk_bf16(a1[0], a1[1]); pk.w = cvt_pk_bf16(a1[2], a1[3]);
                *(LAS u32x4*)(ub_s + tt * 72 + c8 * 8) = pk; }
            LDS_BARRIER();
            {
                const bf16x8 uf0 = *(const LAS bf16x8*)(ub_s + (16 * mt + (lane & 15)) * 72 + 8 * (lane >> 4)), uf1 = *(const LAS bf16x8*)(ub_s + (16 * mt + (lane & 15)) * 72 + 32 + 8 * (lane >> 4));
                const int tt = 16 * mt + (lane & 15);
#pragma unroll
                for (int ntl = 0; ntl < 2; ++ntl) {
                    f32x4 aR = {0.f, 0.f, 0.f, 0.f}, aI = aR;
                    aR = __builtin_amdgcn_mfma_f32_16x16x32_bf16(Wf[0][ntl][0], uf0, aR, 0, 0, 0); aR = __builtin_amdgcn_mfma_f32_16x16x32_bf16(Wf[0][ntl][1], uf1, aR, 0, 0, 0);
                    aI = __builtin_amdgcn_mfma_f32_16x16x32_bf16(Wf[1][ntl][0], uf0, aI, 0, 0, 0); aI = __builtin_amdgcn_mfma_f32_16x16x32_bf16(Wf[1][ntl][1], uf1, aI, 0, 0, 0);
                    const int j0 = 16 * (ntp * 2 + ntl) + 4 * (lane >> 4);
                    const f32x4 uu = *(const LAS f32x4*)(u_s + tt * FP + j0);
                    f32x4 av, bv;
#pragma unroll
                    for (int r = 0; r < 4; ++r) { const float rr = __builtin_amdgcn_rcpf(1.0f + __builtin_amdgcn_exp2f(-1.4426950408889634f * (aR[r] + ba4[ntl][r]))), ig = __builtin_amdgcn_rcpf(1.0f + __builtin_amdgcn_exp2f(-1.4426950408889634f * (aI[r] + bx4[ntl][r])));
                        const float la = rr * nl4[ntl][r], x2 = 2.0f * la;
                        const float a = __builtin_amdgcn_exp2f(1.4426950408889634f * la);
                        const float om = x2 > -0.02f ? -x2 * (1.0f + 0.5f * x2 * (1.0f + 0.33333333f * x2)) : 1.0f - a * a;
                        av[r] = a; bv[r] = __builtin_amdgcn_sqrtf(om) * ig * uu[r]; }
                    *(LAS f32x4*)(a_s + tt * FP + j0) = av; *(LAS f32x4*)(b_s + tt * FP + j0) = bv;
                }
            }
            LDS_BARRIER();
            {
                float av[8], bv[8];
#pragma unroll
                for (int j = 0; j < 8; ++j) { const int sidx = 8 * w + j, tt = dir ? 63 - sidx : sidx; av[j] = a_s[tt * FP + lane]; bv[j] = b_s[tt * FP + lane]; }
                float P = 1.f, Hl = 0.f;
#pragma unroll
                for (int j = 0; j < 8; ++j) { P *= av[j]; Hl = av[j] * Hl + bv[j]; }
                sg_s[w * 64 + lane] = P; sg_s[512 + w * 64 + lane] = Hl;
                LDS_BARRIER();
                float cin = h, cc = h;
#pragma unroll
                for (int j = 0; j < 8; ++j) { if (j == w) cin = cc; cc = sg_s[j * 64 + lane] * cc + sg_s[512 + j * 64 + lane]; }
                h = cc;
#pragma unroll
                for (int j = 0; j < 8; ++j) { cin = av[j] * cin + bv[j]; const int sidx = 8 * w + j, tt = dir ? 63 - sidx : sidx; h_s[tt * FP + lane] = cin; }
            }
            LDS_BARRIER();
            if (seg || ctx_out) for (int i = tid; i < 64 * 16; i += NTHREADS) { const int tt = i >> 4, q4 = i & 15;
                const f32x4 hv = *(const LAS f32x4*)(h_s + tt * FP + q4 * 4); u32x2 hw; hw.x = cvt_pk_bf16(hv[0], hv[1]); hw.y = cvt_pk_bf16(hv[2], hv[3]);
                *(u32x2*)(hd_ + (size_t)(rowbase + t0 + tt) * 512 + blk * 64 + q4 * 4) = hw; }
        }
    }
}
typedef short v4i16_t __attribute__((ext_vector_type(4)));
__device__ __forceinline__ void glds16(const void* gsrc, unsigned lds_dst) { unsigned keep;
    asm volatile("s_mov_b32 %0, m0\n\ts_mov_b32 m0, %2\n\ts_nop 0\n\tglobal_load_lds_dwordx4 %1, off\n\ts_mov_b32 m0, %0" : "=&s"(keep) : "v"(gsrc), "s"(lds_dst) : "memory"); }
__device__ __forceinline__ void attn_unit(Frame& F, int li, int b, int h, int qt) {
    constexpr int KB = 64 * 64 * 2, VB = 64 * 128 * 2, BUF = KB + VB, NBUF = 4;
    int tid = threadIdx.x; LAUNDER_V(tid); LAUNDER_S(li);
    const int lane = tid & 63, w = __builtin_amdgcn_readfirstlane(tid >> 6), r32 = lane & 31, hh = lane >> 5;
    const bool isctx = (qt == 8);
    const int qrow0 = isctx ? b * CTXL : NCTX + b * SEQ + qt * 256;
    const int ntiles = isctx ? 4 : 36;
    const bf16_t* proj = WSP(bf16_t, WS_PROJ);
    float lam;
    { const float* lv = F.in[14] + (size_t)li * 256; const float s1 = wave_sum(lv[lane] * lv[64 + lane], lane), s2 = wave_sum(lv[128 + lane] * lv[192 + lane], lane); const float lam_init = 0.8f - 0.6f * __expf(-0.3f * (float)li); lam = __expf(s1) - __expf(s2) + lam_init; }
    const float lam_init = 0.8f - 0.6f * __expf(-0.3f * (float)li);
    f32x4* o0p = WSP(f32x4, WS_ATT) + ((size_t)F.bid * 512 + tid) * 16;
    const int vtr_base = ((lane >> 4) & 1) * 32 + (lane & 3) * 8 + (4 * hh + ((lane & 15) >> 2)) * 64;
    const unsigned lds0 = (unsigned)(uintptr_t)F.lds;
    const int dk_key = 8 * w + (lane >> 3), dk_col = ((lane & 7) ^ (dk_key & 7)) * 8;
    int dv_key[2], dv_col[2];
#pragma unroll
    for (int j = 0; j < 2; ++j) { const int sidx = 2 * (2 * w + j) + (lane >> 5); dv_key[j] = 8 * (sidx >> 2) + ((lane & 31) >> 2); dv_col[j] = 32 * (sidx & 3) + (lane & 3) * 8; }
    int koff[4];
#pragma unroll
    for (int ks = 0; ks < 4; ++ks) koff[ks] = ((2 * ks + hh) ^ (r32 & 7)) * 16;
#pragma unroll 1
    for (int c = 0; c < 2; ++c) {
        float m_run = 0.f;
        f32x16 o[4]; float lsum = 0.f;
        const bf16x8 ones = (bf16x8){0x3f80, 0x3f80, 0x3f80, 0x3f80, 0x3f80, 0x3f80, 0x3f80, 0x3f80};
#pragma unroll
        for (int et = 0; et < 4; ++et) o[et] = (f32x16){};
        auto dma = [&](int t) {
            const int krow = (t < 4) ? (b * CTXL + t * 64) : (NCTX + b * SEQ + (t - 4) * 64);
            const unsigned base = (unsigned)__builtin_amdgcn_readfirstlane((int)(lds0 + (unsigned)((t & (NBUF - 1)) * BUF + w * 1024)));
            glds16(proj + (size_t)(krow + dk_key) * PW + C_K + h * 128 + c * 64 + dk_col, base);
#pragma unroll
            for (int j = 0; j < 2; ++j) glds16(proj + (size_t)(krow + dv_key[j]) * PW + C_V + h * 128 + dv_col[j], base + (unsigned)(KB + w * 1024 + j * 1024));
        };
        __syncthreads();
        dma(0); dma(1); dma(2); dma(3);
        bf16x8 qf[4];
        { const bf16_t* qp = proj + (size_t)(qrow0 + 32 * w + r32) * PW + C_Q + h * 128 + c * 64 + 8 * hh;
#pragma unroll
          for (int ks = 0; ks < 4; ++ks) qf[ks] = *(const bf16x8*)(qp + 16 * ks); }
        asm volatile("s_waitcnt vmcnt(0)" : "+v"(qf[0]), "+v"(qf[1]), "+v"(qf[2]), "+v"(qf[3]) :: "memory");
        __syncthreads();
#pragma unroll 1
        for (int t = 0; t < ntiles; ++t) {
            const int bsel = t & (NBUF - 1);
            LAS unsigned char* kfp = F.lds + bsel * BUF + r32 * 128; LAS unsigned char* vfp = F.lds + bsel * BUF + KB + vtr_base;
            asm volatile("" : "+v"(kfp)); asm volatile("" : "+v"(vfp));
            f32x16 S[2];
            {   f32x16 negm;
#pragma unroll
                for (int r = 0; r < 16; ++r) negm[r] = -m_run;
                bf16x8 kf0[4], kf1[4];
#pragma unroll
                for (int ks = 0; ks < 4; ++ks) kf0[ks] = *(const LAS bf16x8*)(kfp + koff[ks]);
                __builtin_amdgcn_sched_barrier(0);
#pragma unroll
                for (int ks = 0; ks < 4; ++ks) kf1[ks] = *(const LAS bf16x8*)(kfp + koff[ks] + 4096);
                S[0] = negm;
#pragma unroll
                for (int ks = 0; ks < 4; ++ks) S[0] = __builtin_amdgcn_mfma_f32_32x32x16_bf16(kf0[ks], qf[ks], S[0], 0, 0, 0);
                __builtin_amdgcn_sched_barrier(0);
                S[1] = negm;
#pragma unroll
                for (int ks = 0; ks < 4; ++ks) S[1] = __builtin_amdgcn_mfma_f32_32x32x16_bf16(kf1[ks], qf[ks], S[1], 0, 0, 0); }
            float mx = fmaxf(S[0][0], S[1][0]);
#pragma unroll
            for (int r = 1; r < 16; ++r) mx = fmaxf(fmaxf(mx, S[0][r]), S[1][r]);
            mx = fmaxf(mx, shx(mx, 32, lane));
            if (t == 0 || __any(mx > 8.0f)) {
                const float dl = (t == 0) ? mx : fmaxf(mx, 0.f), alpha = (t == 0) ? 1.0f : __builtin_amdgcn_exp2f(-dl);
                m_run += dl;
#pragma unroll
                for (int kt = 0; kt < 2; ++kt)
#pragma unroll
                    for (int r = 0; r < 16; ++r) S[kt][r] -= dl;
#pragma unroll
                for (int et = 0; et < 4; ++et) o[et] = o[et] * alpha;
                lsum *= alpha;
            }
#pragma unroll
            for (int kt = 0; kt < 2; ++kt)
#pragma unroll
                for (int r = 0; r < 16; ++r) S[kt][r] = __builtin_amdgcn_exp2f(S[kt][r]);
            {   f32x2 rs = {0.f, 0.f};
#pragma unroll
                for (int kt = 0; kt < 2; ++kt)
#pragma unroll
                    for (int r = 0; r < 16; r += 2) rs += (f32x2){S[kt][r], S[kt][r + 1]};
                lsum += rs[0] + rs[1]; }
            bf16x8 pf[2][2];
#pragma unroll
            for (int kt = 0; kt < 2; ++kt)
#pragma unroll
                for (int s2 = 0; s2 < 2; ++s2) { u32x4 pw; pw.x = cvt_pk_bf16(S[kt][8 * s2 + 0], S[kt][8 * s2 + 1]); pw.y = cvt_pk_bf16(S[kt][8 * s2 + 2], S[kt][8 * s2 + 3]);
                    pw.z = cvt_pk_bf16(S[kt][8 * s2 + 4], S[kt][8 * s2 + 5]); pw.w = cvt_pk_bf16(S[kt][8 * s2 + 6], S[kt][8 * s2 + 7]); pf[kt][s2] = __builtin_bit_cast(bf16x8, pw); }
            {
                s16x4 va[2][4][2];
#define ATT_VLOAD(buf, et_) _Pragma("unroll") for (int kk = 0; kk < 4; ++kk) { LAS unsigned char* vp = vfp + ((2 * kk) * 4 + (et_)) * 512; \
                    va[buf][kk][0] = __builtin_bit_cast(s16x4, __builtin_amdgcn_ds_read_tr16_b64_v4i16((LAS v4i16_t*)vp)); va[buf][kk][1] = __builtin_bit_cast(s16x4, __builtin_amdgcn_ds_read_tr16_b64_v4i16((LAS v4i16_t*)(vp + 2048))); }
#define ATT_VMMA(buf, et_) __builtin_amdgcn_s_setprio(1); _Pragma("unroll") for (int kk = 0; kk < 4; ++kk) { const s16x4 lo = va[buf][kk][0], hi = va[buf][kk][1]; const bf16x8 vf = (bf16x8){lo[0], lo[1], lo[2], lo[3], hi[0], hi[1], hi[2], hi[3]}; \
                    o[et_] = __builtin_amdgcn_mfma_f32_32x32x16_bf16(vf, pf[kk >> 1][kk & 1], o[et_], 0, 0, 0); } __builtin_amdgcn_s_setprio(0);
#define ATT_SB __builtin_amdgcn_sched_barrier(0);
                ATT_VLOAD(0, 0) ATT_SB ATT_VLOAD(1, 1) ATT_SB
                ATT_VMMA(0, 0) ATT_SB ATT_VLOAD(0, 2) ATT_SB
                ATT_VMMA(1, 1) ATT_SB ATT_VLOAD(1, 3) ATT_SB
                ATT_VMMA(0, 2) ATT_SB
                ATT_VMMA(1, 3)
#undef ATT_SB
#undef ATT_VLOAD
#undef ATT_VMMA
            }
            if (t + 3 < ntiles) asm volatile("s_waitcnt vmcnt(6)" ::: "memory"); else if (t + 2 < ntiles) asm volatile("s_waitcnt vmcnt(3)" ::: "memory"); else asm volatile("s_waitcnt vmcnt(0)" ::: "memory");
            LDS_BARRIER();
            if (t + 4 < ntiles) dma(t + 4);
        }
        const float inv = __builtin_amdgcn_rcpf(lsum + shx(lsum, 32, lane));
        if (c == 0) {
#pragma unroll
            for (int et = 0; et < 4; ++et)
#pragma unroll
                for (int r4 = 0; r4 < 4; ++r4) o0p[et * 4 + r4] = (f32x4){o[et][4 * r4] * inv, o[et][4 * r4 + 1] * inv, o[et][4 * r4 + 2] * inv, o[et][4 * r4 + 3] * inv};
        } else {
            float ss = 0.f;
            const float li2 = lam * inv;
#pragma unroll
            for (int et = 0; et < 4; ++et) {
#pragma unroll
                for (int r4 = 0; r4 < 4; ++r4) { const f32x4 p0 = o0p[et * 4 + r4];
#pragma unroll
                    for (int q = 0; q < 4; ++q) { const float v = p0[q] - li2 * o[et][4 * r4 + q]; o[et][4 * r4 + q] = v; ss += v * v; } }
            }
            ss += shx(ss, 32, lane);
            const float rn = __builtin_amdgcn_rsqf(ss * (1.f / 128.f) + 1e-5f) * (1.0f - lam_init);
            LAS bf16_t* st = (LAS bf16_t*)(F.lds + w * (32 * 136 * 2));
#pragma unroll
            for (int et = 0; et < 4; ++et)
#pragma unroll
                for (int r = 0; r < 16; ++r) { const int e = 32 * et + (r & 3) + 8 * (r >> 2) + 4 * hh; st[r32 * 136 + e] = f2bf(o[et][r] * rn); }
            LDS_WAIT(); asm volatile("" ::: "memory");
            const float* sw = F.in[15] + (size_t)li * 128 + (lane & 15) * 8;
            const f32x4 sw0 = *(const f32x4*)sw, sw1 = *(const f32x4*)(sw + 4);
#pragma unroll
            for (int i = 0; i < 8; ++i) { const int idx = i * 64 + lane, q = idx >> 4, ch = idx & 15;
                const u32x4 v = *(const LAS u32x4*)(st + q * 136 + ch * 8);
                u32x4 ov; ov.x = cvt_pk_bf16(lo_bf(v.x) * sw0[0], hi_bf(v.x) * sw0[1]); ov.y = cvt_pk_bf16(lo_bf(v.y) * sw0[2], hi_bf(v.y) * sw0[3]);
                ov.z = cvt_pk_bf16(lo_bf(v.z) * sw1[0], hi_bf(v.z) * sw1[1]); ov.w = cvt_pk_bf16(lo_bf(v.w) * sw1[2], hi_bf(v.w) * sw1[3]);
                *(u32x4*)(WSP(bf16_t, WS_YS) + (size_t)(qrow0 + 32 * w + q) * 2048 + 1024 + h * 128 + ch * 8) = ov; }
        }
    }
}
__device__ __forceinline__ void p2_mixers(Frame& F, int li, int rep) {
    const bool need_ctx = (li < DEPTH - 1);
    const int n3 = need_ctx ? 960 : 896;
    volatile LAS int* qslot = (volatile LAS int*)(F.lds + MISC_OFF + 64);
    unsigned* qhead = WSP(unsigned, WS_CTL) + CW_QHEAD + (li * 2 + rep) * 64;
    for (;;) {
        __syncthreads();
        if (threadIdx.x == 0) *qslot = (int)__hip_atomic_fetch_add(qhead, 1u, __ATOMIC_RELAXED, __HIP_MEMORY_SCOPE_AGENT);
        __syncthreads();
        const int u = *qslot;
        if (u >= n3) break;
#ifndef TESTUNIT
#define TESTUNIT 15
#endif
#ifndef REPUNIT
#define REPUNIT 0
#endif
#define UREP(j) _Pragma("unroll 1") for (int urep_ = 0; urep_ < (((REPUNIT >> (j)) & 1) ? 2 : 1); ++urep_)
        if (u < 128) { if (TESTUNIT & 1) UREP(0) ssd_unit2(F, li, u >> 3, (u >> 1) & 3, u & 1, need_ctx); }
        else if (u < 640) { const int v = u - 128; if (TESTUNIT & 4) UREP(2) attn_unit(F, li, v >> 5, (v >> 3) & 3, v & 7); }
        else if (u < 896) { const int v = u - 640; if (TESTUNIT & 2) UREP(1) rglru_unit(F, li, v >> 4, (v >> 1) & 7, v & 1, need_ctx); }
        else { const int q = u - 896; if (TESTUNIT & 4) UREP(3) attn_unit(F, li, q >> 2, q & 3, 8); }
    }
}

__device__ __forceinline__ bool in_range_(int lo, int hi, int k) { asm volatile("" : "+s"(k)); return lo <= k && k < hi; }
struct Args { const float* in[37]; float* out; unsigned char* ws; int ph_lo, ph_hi; };
constexpr int NPH = 2 + DEPTH * 9;
__global__ void __launch_bounds__(NTHREADS, 2) fwd_kernel(Args args) {
    extern __shared__ __attribute__((aligned(16))) unsigned char lds_raw[];
    Frame F;
    F.lds = (LAS unsigned char*)lds_raw;
    F.G = gridDim.x; F.bid = blockIdx.x;
    F.in = args.in;
    F.out = args.out; F.ws = args.ws;
    volatile LAS unsigned* MISC = (volatile LAS unsigned*)(F.lds + MISC_OFF);
    if (threadIdx.x < 4) MISC[threadIdx.x] = 0u;
    __syncthreads();
    const int lo = args.ph_lo, hi = args.ph_hi;
    XcdBarrier bar; bar.bar = WSP(unsigned, WS_CTL) + CW_BAR; bar.x = 0; bar.st = nullptr;
    if (hi - lo > 1) bar = xcd_barrier_post(WSP(unsigned, WS_CTL) + CW_BAR, MISC);
#ifdef TESTPH
#define PH_EN(k) (((k) < 2 ? (k) : 2 + ((k) - 2) % 9) == TESTPH)
#else
#define PH_EN(k) true
#endif
#define IN(k) (PH_EN(k) && in_range_(lo, hi, (k)))
#ifndef BARX
#define BARX 0
#endif
#define SEAM(k) do { if (in_range_(lo, hi - 1, (k))) { xcd_barrier(bar); if (BARX) xcd_barrier(bar); } } while (0)
#ifndef REPMASK
#define REPMASK 0
#endif
#define NREP(j) (((REPMASK >> (j)) & 1) ? 2 : 1)
#define REPEAT(j) _Pragma("unroll 1") for (int rep_ = 0; rep_ < NREP(j); ++rep_)

#ifndef P0SEL
#define P0SEL 3
#endif
    if (IN(0)) { REPEAT(10) { if (rep_ == 0 || (P0SEL & 1)) p0_weights(F); if (rep_ == 0 || (P0SEL & 2)) p0_mod(F); } } SEAM(0);
    if (IN(1)) { REPEAT(11) { p1_rows(F); } } SEAM(1);
#pragma unroll 1
    for (int li = 0; li < DEPTH; ++li) {
        const int pb = 2 + li * 9;
        const bool need_ctx = (li < DEPTH - 1);
        const int pm0 = need_ctx ? 0 : 16;
        const int row_lo = pm0 * 256;
        if (IN(pb + 0)) REPEAT(0) {
            int li_ = li; LAUNDER_S(li_);
            SchedGrid S{NTOK / 256, PW / 256, F.G, F.bid, 0, (const char*)WSP(bf16_t, WS_H), (const char*)(WSP(bf16_t, WS_WIN) + (size_t)li_ * PW * 1024), (size_t)256 * 2048, (size_t)256 * 2048};
            EpiProj E{WSP(bf16_t, WS_PROJ), WSP(float, WS_ROPE), WSP(float, WS_ROPE) + 1024, WSP(unsigned char, WS_XG)};
            pg8::gemm_phase(F.lds, 1024, 2048u, 2048u, S, E);
        } SEAM(pb + 0);
        if (IN(pb + 1)) REPEAT(1) { p2_mixers(F, li, rep_); } SEAM(pb + 1);
        if (IN(pb + 2)) REPEAT(2) { p2b_rows(F, li, row_lo); } SEAM(pb + 2);
        if (IN(pb + 3)) REPEAT(3) {   int li_ = li; LAUNDER_S(li_);
            SchedQuad S{NTOK / 128 - 2 * pm0, 8, F.G, F.bid, 2 * pm0, (const char*)WSP(bf16_t, WS_YS), (const char*)(WSP(bf16_t, WS_WBR) + (size_t)li_ * 2 * 1024 * 1024)};
            EpiQuad E{WSP(unsigned char, WS_XG), WSP(bf16_t, WS_M)};
            pg8::gemm_phase<EpiQuad, SchedQuad, true>(F.lds, 1024, 4096u, 2048u, S, E);
        } SEAM(pb + 3);
        if (IN(pb + 4)) REPEAT(4) {
            int li_ = li; LAUNDER_S(li_); const bool dry = (NREP(4) == 2) && rep_ == 0;
            SchedGrid S{NTOK / 256 - pm0, 4, F.G, F.bid, pm0, (const char*)WSP(bf16_t, WS_M), (const char*)(WSP(bf16_t, WS_WOUT) + (size_t)li_ * 1024 * 1024), (size_t)256 * 2048, (size_t)256 * 2048};
            EpiOut E{WSP(bf16_t, WS_MACC), WSP(float, WS_MOD) + (size_t)li_ * 17 * 6144}; (void)dry;
            pg8::gemm_phase(F.lds, 1024, 2048u, 2048u, S, E);
        } SEAM(pb + 4);
        if (IN(pb + 5)) REPEAT(5) { p5_rows(F, li, row_lo, (NREP(5) == 2) && rep_ == 0); } SEAM(pb + 5);
        if (IN(pb + 6)) REPEAT(7) {
            int li_ = li; LAUNDER_S(li_);
            LAS int* tstart = (LAS int*)(F.lds + XTRA_OFF);
            LAS unsigned short* toks = (LAS unsigned short*)(F.lds + XTRA_OFF + 256);
            moe_tstart(F, li_, tstart);
            moe_toks(F, li_, tstart, toks, 8);
            SchedMoe S{tstart, toks, 8, F.G, F.bid, (const char*)WSP(bf16_t, WS_H), (const char*)(WSP(bf16_t, WS_WGU) + (size_t)li_ * 32 * 2048 * 1024), (size_t)0, (size_t)256 * 2048, (size_t)2048 * 2048};
            EpiGU E{WSP(bf16_t, WS_HID), F.in[34] + (size_t)li_ * 32 * 2048};
            pg8::gemm_phase(F.lds, 1024, 2048u, 2048u, S, E);
        } SEAM(pb + 6);
        if (IN(pb + 7)) REPEAT(8) {
            int li_ = li; LAUNDER_S(li_);
            LAS int* tstart = (LAS int*)(F.lds + XTRA_OFF);
            moe_tstart(F, li_, tstart);
            SchedMoe S{tstart, nullptr, 4, F.G, F.bid, (const char*)WSP(bf16_t, WS_HID), (const char*)(WSP(bf16_t, WS_WD) + (size_t)li_ * 32 * 1024 * 1024), (size_t)256 * 2048, (size_t)256 * 2048, (size_t)1024 * 2048};
            EpiDown E{WSP(unsigned char, WS_Y2), F.in[36] + (size_t)li_ * 32 * 1024, WSP(int, WS_ELIST), WSP(unsigned, WS_CTL) + CW_ECNT + li_ * 32 * 64};
            pg8::gemm_phase(F.lds, 1024, 2048u, 2048u, S, E);
        } SEAM(pb + 7);
        if (IN(pb + 8)) REPEAT(9) { p9_rows(F, li, row_lo, (NREP(9) == 2) && rep_ == 0); } SEAM(pb + 8);
    }
#undef IN
#undef SEAM
}

extern "C" void kernel_launch(void* const* d_in, const int* in_sizes, int n_in, void* d_out, int out_size, void* d_ws, size_t ws_size, hipStream_t stream) {
    static int grid = 0;
    if (grid == 0) {
        if (n_in != 37 || out_size != NLAT * D || ws_size < WS_END) { fprintf(stderr, "kernel_launch: unexpected shapes (n_in %d, out %d, ws %zu < %zu)\n", n_in, out_size, ws_size, (size_t)WS_END); grid = -1; return; }
        int dev = 0, cus = 0, per_cu = 0;
        if (hipGetDevice(&dev) != hipSuccess || hipDeviceGetAttribute(&cus, hipDeviceAttributeMultiprocessorCount, dev) != hipSuccess) { grid = -1; return; }
        if (hipFuncSetAttribute((const void*)fwd_kernel, hipFuncAttributeMaxDynamicSharedMemorySize, LDS_BYTES) != hipSuccess) { fprintf(stderr, "kernel_launch: hipFuncSetAttribute failed\n"); grid = -1; return; }
        if (hipOccupancyMaxActiveBlocksPerMultiprocessor(&per_cu, (const void*)fwd_kernel, NTHREADS, LDS_BYTES) != hipSuccess || per_cu < 1) { fprintf(stderr, "kernel_launch: occupancy query says %d\n", per_cu); }
        (void)hipGetLastError();
        grid = cus;
        if (grid != 256) fprintf(stderr, "kernel_launch: %d CUs (built for 256)\n", grid);
    }
    if (grid < 0) return;
    (void)hipMemsetAsync((char*)d_ws + WS_CTL, 0, CTL_BYTES, stream);
    Args a{};
    for (int i = 0; i < 37; ++i) a.in[i] = (const float*)d_in[i];
    a.out = (float*)d_out; a.ws = (unsigned char*)d_ws;
#if MK_N_LAUNCHES == 1
    a.ph_lo = 0; a.ph_hi = NPH;
    hipLaunchKernelGGL(fwd_kernel, dim3(grid), dim3(NTHREADS), LDS_BYTES, stream, a);
#else
    for (int p = 0; p < NPH; ++p) { a.ph_lo = p; a.ph_hi = p + 1; hipLaunchKernelGGL(fwd_kernel, dim3(grid), dim3(NTHREADS), LDS_BYTES, stream, a); }
#endif
    const hipError_t le = hipPeekAtLastError();
    if (le != hipSuccess) fprintf(stderr, "kernel_launch: launch failed: %s\n", hipGetErrorName(le));
}
```

```cpp
#include <hip/hip_runtime.h>
#include <cstdio>
#include <cstdint>

#ifndef MK_N_LAUNCHES
#define MK_N_LAUNCHES 1
#endif

#define GAS __attribute__((address_space(1)))
#define LAS __attribute__((address_space(3)))
typedef unsigned short bf16_t;
typedef short bf16x8 __attribute__((ext_vector_type(8)));
typedef short s16x4 __attribute__((ext_vector_type(4)));
typedef float f32x2 __attribute__((ext_vector_type(2)));
typedef float f32x4 __attribute__((ext_vector_type(4)));
typedef float f32x16 __attribute__((ext_vector_type(16)));
typedef unsigned u32x2 __attribute__((ext_vector_type(2)));
typedef unsigned u32x4 __attribute__((ext_vector_type(4)));

constexpr int D = 1024, NBATCH = 16, SEQ = 2048, CTXL = 256, DEPTH = 4;
constexpr int NCTX = NBATCH * CTXL;
constexpr int NLAT = NBATCH * SEQ;
constexpr int NTOK = NCTX + NLAT;
constexpr int PW = 8448;
constexpr int C_RX = 0, C_RG = 512, C_Q = 1024, C_K = 1536, C_V = 2048, C_PU = 2560, C_Z = 3072, C_XBC = 3584, C_MG = 4352;
constexpr int INW = 8464;
constexpr int NEXP = 32, ECAP = NTOK;
constexpr int NSLOT = NTOK * 4 + NEXP * 256;
constexpr float DN_ALPHA = 1.6817928305074290f;
constexpr int NWAVES = 8, NTHREADS = 512;
constexpr float QSCALE = 0.125f * 1.4426950408889634f;

constexpr size_t al256(size_t x) { return (x + 255) & ~(size_t)255; }
constexpr size_t WS_CTL = 0, CTL_BYTES = 1u << 20;
constexpr size_t WS_MOD = WS_CTL + CTL_BYTES;
constexpr size_t WS_ROPE = WS_MOD + al256((size_t)DEPTH * 17 * 6144 * 4);
constexpr size_t WS_WDT = WS_ROPE + 8192;
constexpr size_t WS_ROUT = WS_WDT + (size_t)DEPTH * 16 * 1024 * 4;
constexpr size_t WS_WIN = WS_ROUT + (size_t)DEPTH * 32 * 1024 * 4;
constexpr size_t WS_WGU = WS_WIN + (size_t)DEPTH * PW * 1024 * 2;
constexpr size_t WS_WD = WS_WGU + (size_t)DEPTH * 32 * 2048 * 1024 * 2;
constexpr size_t WS_WBR = WS_WD + (size_t)DEPTH * 32 * 1024 * 1024 * 2;
constexpr size_t WS_WOUT = WS_WBR + (size_t)DEPTH * 4 * 1024 * 512 * 2;
constexpr size_t WS_POOLW = WS_WOUT + (size_t)DEPTH * 1024 * 1024 * 2;
constexpr size_t WS_RNNW = WS_POOLW + (size_t)DEPTH * 4 * 128 * 128 * 2;
constexpr size_t WS_XL = WS_RNNW + (size_t)DEPTH * 2 * 2 * 8 * 64 * 64 * 2;
constexpr size_t WS_H = WS_XL + (size_t)NTOK * 1024 * 4;
constexpr size_t WS_PROJ = WS_H + (size_t)NTOK * 1024 * 2;
constexpr size_t WS_DT = WS_PROJ + (size_t)NTOK * PW * 2;
constexpr size_t WS_HF = WS_DT + (size_t)NTOK * 16 * 4;
constexpr size_t WS_HB = WS_HF + (size_t)NTOK * 512 * 4;
constexpr size_t WS_YF = WS_HB + (size_t)NTOK * 512 * 4;
constexpr size_t WS_YB = WS_YF + (size_t)NTOK * 512 * 4;
constexpr size_t WS_YS = WS_YB + (size_t)NTOK * 512 * 4;
constexpr size_t WS_MACC = WS_YS + (size_t)NTOK * 2048 * 2;
constexpr size_t WS_M = WS_MACC + (size_t)NTOK * 1024 * 4;
constexpr size_t WS_EP = WS_M + (size_t)NTOK * 1024 * 2;
constexpr size_t WS_ELIST = WS_EP + (size_t)NTOK * 4 * 4;
constexpr size_t WS_XG = WS_ELIST + (size_t)NEXP * ECAP * 4;
constexpr size_t WS_HID = WS_XG + (size_t)NSLOT * 1024 * 2;
constexpr size_t WS_Y2 = WS_HID + (size_t)NSLOT * 1024 * 2;
constexpr size_t WS_ATT = WS_Y2 + (size_t)NTOK * 4 * 1024 * 2;
constexpr size_t WS_END = WS_ATT + (size_t)256 * 16 * 512 * 16;
constexpr int CW_BAR = 4096;
constexpr int CW_ECNT = 16384;
constexpr int CW_QHEAD = 32768;

constexpr int SCR_BYTES = 131072;
constexpr int XTRA_OFF = SCR_BYTES;
constexpr int MISC_OFF = SCR_BYTES + 15872;
constexpr int XTRA2_OFF = 147456;
constexpr int LDS_BYTES = 163840;

__device__ __forceinline__ float bf2f(bf16_t b) { return __uint_as_float(((unsigned)b) << 16); }
__device__ __forceinline__ unsigned cvt_pk_bf16(float lo, float hi) { unsigned r; asm volatile("v_cvt_pk_bf16_f32 %0, %1, %2" : "=v"(r) : "v"(lo), "v"(hi)); return r; }
__device__ __forceinline__ bf16_t f2bf(float f) { return (bf16_t)(cvt_pk_bf16(f, 0.f) & 0xffffu); }
__device__ __forceinline__ float lo_bf(unsigned w) { return __uint_as_float(w << 16); }
__device__ __forceinline__ float hi_bf(unsigned w) { return __uint_as_float(w & 0xffff0000u); }
__device__ __forceinline__ float sigmoidf_(float x) { return __builtin_amdgcn_rcpf(1.0f + __builtin_amdgcn_exp2f(-1.4426950408889634f * x)); }
__device__ __forceinline__ float siluf_(float x) { return x * __builtin_amdgcn_rcpf(1.0f + __builtin_amdgcn_exp2f(-1.4426950408889634f * x)); }
__device__ __forceinline__ float softplusf_(float x) { const float e = __expf(x); return x > 20.f ? x : (e < 1e-4f ? e * (1.0f - 0.5f * e) : __logf(1.0f + e)); }
__device__ __forceinline__ float gelu_tanh(float x) { const float u = 0.7978845608028654f * (x + 0.044715f * x * x * x); const float e = __builtin_amdgcn_exp2f(2.8853900817779268f * u); const float t = 1.f - 2.f * __builtin_amdgcn_rcpf(e + 1.f); return 0.5f * x * (1.f + t); }
__device__ __forceinline__ f32x4 sig4_(f32x4 t) { f32x4 e; _Pragma("unroll") for (int j = 0; j < 4; ++j) e[j] = __builtin_amdgcn_exp2f(t[j]); e = e + 1.0f; f32x4 r; _Pragma("unroll") for (int j = 0; j < 4; ++j) r[j] = __builtin_amdgcn_rcpf(e[j]); return r; }
__device__ __forceinline__ f32x4 silu4_(f32x4 x) { return x * sig4_(x * -1.4426950408889634f); }
__device__ __forceinline__ f32x4 gelu4_(f32x4 x) { const f32x4 x2 = x * x; return x * sig4_(x * (x2 * (-2.0f * 0.7978845608028654f * 0.044715f * 1.4426950408889634f) + (-2.0f * 0.7978845608028654f * 1.4426950408889634f))); }
__device__ __forceinline__ f32x4 bf4lo_(u32x4 v) { return (f32x4){lo_bf(v.x), hi_bf(v.x), lo_bf(v.y), hi_bf(v.y)}; }
__device__ __forceinline__ f32x4 bf4hi_(u32x4 v) { return (f32x4){lo_bf(v.z), hi_bf(v.z), lo_bf(v.w), hi_bf(v.w)}; }
__device__ __forceinline__ int shxi(int v, int o, int lane) {
    if (__builtin_constant_p(o)) {
        if (o == 32) { const auto rr = __builtin_amdgcn_permlane32_swap((unsigned)v, (unsigned)v, false, false); return (lane & 32) ? (int)rr[0] : (int)rr[1]; }
        if (o == 16) { const auto rr = __builtin_amdgcn_permlane16_swap((unsigned)v, (unsigned)v, false, false); return (lane & 16) ? (int)rr[0] : (int)rr[1]; }
        if (o == 8) return __builtin_amdgcn_update_dpp(0, v, 0x140, 0xf, 0xf, true);
        if (o == 4) return __builtin_amdgcn_update_dpp(0, v, 0x141, 0xf, 0xf, true);
        if (o == 2) return __builtin_amdgcn_update_dpp(0, v, 0x4E, 0xf, 0xf, true);
        if (o == 1) return __builtin_amdgcn_update_dpp(0, v, 0xB1, 0xf, 0xf, true);
    }
    return __builtin_amdgcn_ds_bpermute((lane ^ o) << 2, v);
}
__device__ __forceinline__ float shx(float v, int o, int lane) { return __int_as_float(shxi(__float_as_int(v), o, lane)); }
__device__ __forceinline__ float shl_(float v, int src_lane) { return __int_as_float(__builtin_amdgcn_ds_bpermute(src_lane << 2, __float_as_int(v))); }
__device__ __forceinline__ float wave_sum(float v, int lane) {
#pragma unroll
    for (int o = 1; o < 64; o <<= 1) v += shx(v, o, lane);
    return v;
}
template <int H, int OFF, int NN> __device__ __forceinline__ void bfly_rec(float (&p)[NN], int lane) {
    if constexpr (H >= 1) {
        const bool up = (lane & OFF) != 0;
#pragma unroll
        for (int i = 0; i < H; ++i) { const float keep = up ? p[H + i] : p[i]; const float send = up ? p[i] : p[H + i]; p[i] = keep + shx(send, OFF, lane); }
        bfly_rec<H / 2, OFF / 2, NN>(p, lane);
    }
}
template <int N> __device__ __forceinline__ float bfly_reduce(float (&p)[N], int lane) {
    bfly_rec<N / 2, 32, N>(p, lane);
    float v = p[0];
#pragma unroll
    for (int off = (64 / N) / 2; off >= 1; off >>= 1) v += shx(v, off, lane);
    return v;
}

#define XB_TMO      128
#define XB_XCNT(j)  (256  + 64 * (j))
#define XB_XSUB(j)  (1280 + 64 * (j))
#define XB_XGEN(j)  (2304 + 64 * (j))
#define XB_TOP      3328
#define XB_TOPGEN   3392
#define XCD_BAR_WORDS 3456
#define XB_SPIN_CAP (1u << 20)
__device__ __forceinline__ unsigned xb_ld(unsigned* p)              { return __hip_atomic_load(p, __ATOMIC_RELAXED, __HIP_MEMORY_SCOPE_AGENT); }
__device__ __forceinline__ unsigned xb_add(unsigned* p, unsigned v) { return __hip_atomic_fetch_add(p, v, __ATOMIC_RELAXED, __HIP_MEMORY_SCOPE_AGENT); }
__device__ __forceinline__ unsigned xb_xcc_id() { return (unsigned)__builtin_amdgcn_s_getreg((3 << 11) | 20) & 0xFu; }
#define XB_SPIN(cond, bar) do { unsigned _sp = 0; while (cond) { __builtin_amdgcn_s_sleep(1); \
    if ((++_sp & 255u) == 0u) { if (xb_ld(&(bar)[XB_TMO])) break; if (_sp > XB_SPIN_CAP) { atomicAdd(&(bar)[XB_TMO], 1u); break; } } } } while (0)
struct XcdBarrier { unsigned* bar; unsigned x; volatile LAS unsigned* st; };
__device__ __forceinline__ XcdBarrier xcd_barrier_post(unsigned* bar, volatile LAS unsigned* st) {
    XcdBarrier b; b.bar = bar; b.x = xb_xcc_id(); b.st = st;
    if (threadIdx.x == 0) (void)xb_add(&bar[XB_XCNT(b.x)], 1u);
    return b;
}
__device__ __forceinline__ void xcd_barrier_complete(unsigned* bar, unsigned x, unsigned& nloc, unsigned& nx) {
    const unsigned G = gridDim.x * gridDim.y * gridDim.z;
    unsigned sum, cnt, mine, sp = 0u;
    for (;;) {
        sum = 0u; cnt = 0u; mine = 0u;
#pragma unroll
        for (unsigned j = 0; j < 16; ++j) { const unsigned c = xb_ld(&bar[XB_XCNT(j)]); sum += c; cnt += (c > 0u) ? 1u : 0u; mine = (j == x) ? c : mine; }
        if (sum == G) break;
        __builtin_amdgcn_s_sleep(1);
        if ((++sp & 255u) == 0u) { if (xb_ld(&bar[XB_TMO])) break; if (sp > XB_SPIN_CAP) { atomicAdd(&bar[XB_TMO], 1u); break; } }
    }
    nloc = mine > 0u ? mine : 1u; nx = cnt > 0u ? cnt : 1u;
}
__device__ __forceinline__ void xcd_barrier(const XcdBarrier& b) {
    asm volatile("s_waitcnt vmcnt(0)" ::: "memory");
    __syncthreads();
    if (threadIdx.x == 0) {
        unsigned* bar = b.bar;
        __builtin_amdgcn_s_waitcnt(0);
        unsigned nloc = b.st[0], nx = b.st[1];
        if (nloc == 0u) { xcd_barrier_complete(bar, b.x, nloc, nx); b.st[0] = nloc; b.st[1] = nx; }
        const unsigned old = xb_add(&bar[XB_XSUB(b.x)], 1u);
        const unsigned gen = old / nloc;
        if (old + 1u == (gen + 1u) * nloc) {
            __builtin_amdgcn_fence(__ATOMIC_RELEASE, "agent");
            asm volatile("s_waitcnt vmcnt(0)" ::: "memory");
            const unsigned og = xb_add(&bar[XB_TOP], 1u);
            const unsigned tg = og / nx;
            if (og + 1u == (tg + 1u) * nx) xb_add(&bar[XB_TOPGEN], 1u);
            else XB_SPIN(xb_ld(&bar[XB_TOPGEN]) == tg, bar);
            __builtin_amdgcn_fence(__ATOMIC_ACQUIRE, "agent");
            xb_add(&bar[XB_XGEN(b.x)], 1u);
            asm volatile("s_waitcnt vmcnt(0)" ::: "memory");
        } else {
            XB_SPIN(xb_ld(&bar[XB_XGEN(b.x)]) == gen, bar);
            __builtin_amdgcn_fence(__ATOMIC_ACQUIRE, "agent");
            asm volatile("s_waitcnt vmcnt(0)" ::: "memory");
        }
    }
    __syncthreads();
}

struct Frame {
    LAS unsigned char* lds;
    int G, bid;
    const float* const* in;
    float* out; unsigned char* ws;
};
#define WSP(T, off) ((T*)(F.ws + (off)))
#define LAUNDER_V(x) asm volatile("" : "+v"(x))
#define LAUNDER_S(x) asm volatile("" : "+s"(x))

namespace pg8 {
constexpr int BM = 256, BK = 64, HALF = 128, HTB = HALF * BK * 2, STAGE_BYTES = 8 * HTB, NXCD = 8, WGM = 8;
__host__ __device__ __forceinline__ int lds_byte(int r, int c) { const int st = (r >> 4) * 2 + (c >> 5), rr = r & 15, cc = c & 31, ob = rr * 64 + cc * 2; return st * 1024 + (ob ^ (((ob >> 9) & 1) << 5)); }
__host__ __device__ __forceinline__ void stage_rc(int b, int& R, int& C) { const int st = b / 1024, sb = b % 1024, swz = sb ^ (((sb >> 9) & 1) << 5); R = (st >> 1) * 16 + swz / 64; C = (st & 1) * 32 + (swz % 64) / 2; }
__host__ __device__ __forceinline__ int perm32(int rho) { const int n = rho >> 4, i = rho & 15; return 8 * (i >> 2) + 4 * n + (i & 3); }

struct Unit { const char* a; const char* b; int pm, pn, e, aux; };
__device__ __forceinline__ void tile_of(int L, int nM, int nN, int& pm, int& pn) {
    const int nwg = nM * nN; int wgid = L; { const int q = nwg / NXCD, r = nwg % NXCD, xcd = wgid % NXCD, off = wgid / NXCD; wgid = (xcd < r ? xcd * (q + 1) : r * (q + 1) + (xcd - r) * q) + off; }
    const int nig = WGM * nN, gid = wgid / nig, fm = gid * WGM, gsz = (nM - fm) < WGM ? (nM - fm) : WGM;
    pm = fm + ((wgid % nig) % gsz); pn = (wgid % nig) / gsz;
}

template <class Epi, class Sched, bool QUAD = false>
__device__ __forceinline__ void gemm_phase(LAS unsigned char* lds, const int K, const unsigned lda, const unsigned ldb, const Sched& S, const Epi& E) {
    int tid = threadIdx.x; LAUNDER_V(tid);
    const int wid = __builtin_amdgcn_readfirstlane(tid >> 6), lane = tid & 63, wr = wid >> 2, wc = wid & 3, fr = lane & 15, fq = lane >> 4;
    const int nt = K / BK;
    unsigned voffB[2]; int sR[2], sC[2];
#pragma unroll
    for (int i = 0; i < 2; ++i) { int R, C; stage_rc(tid * 16 + i * 8192, R, C); const int Rb = Epi::PERM ? ((R & ~31) + perm32(R & 31)) : R;
        sR[i] = R; sC[i] = C; voffB[i] = (unsigned)Rb * ldb + (unsigned)C * 2u; }
    unsigned voffA[2][2];
    const size_t kstep = (size_t)(BK * 2);
    const size_t hstepB = S.hstep_b(ldb);
    const unsigned ldsw = (unsigned)wid * 1024u;
    const int aoff = lds_byte(wr * 64 + fr, fq * 8), boff = lds_byte(wc * 32 + fr, fq * 8);
#define PG8_SA(b, h) (((b) * 2 + (h)) * HTB)
#define PG8_SB(b, h) ((4 + (b) * 2 + (h)) * HTB)
#define PG8_STAGE(bufoff, gbase, voff) do { _Pragma("unroll") for (int _i = 0; _i < 2; ++_i) \
        __builtin_amdgcn_global_load_lds((const unsigned*)((const char*)(gbase) + (voff)[_i]), (LAS unsigned*)(lds + (bufoff) + ldsw + _i * 8192), 16, 0, 0); } while (0)
#define PG8_LDA(dst, b, h) do { _Pragma("unroll") for (int m = 0; m < 4; ++m) _Pragma("unroll") for (int k = 0; k < 2; ++k) dst[m][k] = *(const LAS bf16x8*)(lds + PG8_SA(b, h) + aoff + m * 2048 + k * 1024); } while (0)
#define PG8_LDB(dst, b, h) do { _Pragma("unroll") for (int n = 0; n < 2; ++n) _Pragma("unroll") for (int k = 0; k < 2; ++k) dst[n][k] = *(const LAS bf16x8*)(lds + PG8_SB(b, h) + boff + n * 2048 + k * 1024); } while (0)
#define PG8_MMA(ai, bj, At, Bt) do { __builtin_amdgcn_s_setprio(1); _Pragma("unroll") for (int m = 0; m < 4; ++m) _Pragma("unroll") for (int n = 0; n < 2; ++n) _Pragma("unroll") for (int k = 0; k < 2; ++k) \
        acc[ai][bj][m][n] = __builtin_amdgcn_mfma_f32_16x16x32_bf16(Bt[n][k], At[m][k], acc[ai][bj][m][n], 0, 0, 0); __builtin_amdgcn_s_setprio(0); } while (0)
#define PG8_WAIT_V(n) asm volatile("s_waitcnt vmcnt(" #n ")" ::: "memory")
#define PG8_WAIT_L(n) asm volatile("s_waitcnt lgkmcnt(" #n ")" ::: "memory")
#define PG8_BAR __builtin_amdgcn_s_barrier()
#define PG8_SCHED __builtin_amdgcn_sched_barrier(0)
    Unit cur, nxt; int ui = 0;
    if (!S.next(0, cur)) return;
    f32x4 acc[2][2][4][2];
#pragma unroll
    for (int a = 0; a < 2; ++a)
#pragma unroll
        for (int b = 0; b < 2; ++b)
#pragma unroll
            for (int m = 0; m < 4; ++m)
#pragma unroll
                for (int n = 0; n < 2; ++n) acc[a][b][m][n] = (f32x4){0.f, 0.f, 0.f, 0.f};
    bf16x8 At[4][2], B0[2][2], B1[2][2];
    const char* cA = cur.a; const char* cB = cur.b;
    S.aoff(cur, sR, sC, lda, voffA);
    PG8_STAGE(PG8_SB(0, 0), cB, voffB); PG8_STAGE(PG8_SB(0, 1), cB + hstepB, voffB); PG8_STAGE(PG8_SA(0, 0), cA, voffA[0]); PG8_STAGE(PG8_SA(0, 1), cA, voffA[1]);
    if (wr == 1) PG8_BAR;
    PG8_WAIT_V(2); PG8_BAR;
    PG8_STAGE(PG8_SB(1, 0), cB + kstep, voffB); PG8_STAGE(PG8_SA(1, 0), cA + kstep, voffA[0]); PG8_STAGE(PG8_SB(1, 1), cB + hstepB + kstep, voffB);
    PG8_WAIT_V(6); PG8_BAR;
    for (;;) {
        const bool has_next = S.next(ui + 1, nxt);
        const char* nA = has_next ? nxt.a : cA; const char* nB = has_next ? nxt.b : cB;
#define PG8_TRIP(MMA_A0, MMA_A1) { \
            const bool last = (t == nt - 2); \
            const char* a1 = cA + (size_t)(t + 1) * kstep; \
            const char* a2 = last ? nA : cA + (size_t)(t + 2) * kstep; const char* b2 = last ? nB : cB + (size_t)(t + 2) * kstep; \
            const char* a3 = a2 + kstep; const char* b3 = b2 + kstep; \
            PG8_LDB(B0, 0, 0); PG8_LDB(B1, 0, 1); PG8_SCHED; PG8_LDA(At, 0, 0); PG8_STAGE(PG8_SA(1, 1), a1, voffA[1]); \
            if (last && has_next) S.aoff(nxt, sR, sC, lda, voffA);     \
            PG8_WAIT_V(8); PG8_WAIT_L(0); PG8_BAR; MMA_A0; PG8_BAR; PG8_SCHED; \
            PG8_LDA(At, 0, 1); PG8_STAGE(PG8_SB(0, 0), b2, voffB); PG8_STAGE(PG8_SB(0, 1), b2 + hstepB, voffB); PG8_STAGE(PG8_SA(0, 0), a2, voffA[0]); \
            PG8_WAIT_V(8); PG8_WAIT_L(0); PG8_BAR; MMA_A1; PG8_BAR; PG8_SCHED; \
            PG8_LDB(B0, 1, 0); PG8_LDB(B1, 1, 1); PG8_SCHED; PG8_LDA(At, 1, 0); PG8_STAGE(PG8_SA(0, 1), a2, voffA[1]); \
            PG8_WAIT_V(8); PG8_WAIT_L(0); PG8_BAR; MMA_A0; PG8_BAR; PG8_SCHED; \
            PG8_LDA(At, 1, 1); PG8_STAGE(PG8_SB(1, 0), b3, voffB); PG8_STAGE(PG8_SB(1, 1), b3 + hstepB, voffB); PG8_STAGE(PG8_SA(1, 0), a3, voffA[0]); \
            PG8_WAIT_V(8); PG8_WAIT_L(0); PG8_BAR; MMA_A1; PG8_BAR; PG8_SCHED; }
        if constexpr (!QUAD) {
            for (int t = 0; t < nt; t += 2) PG8_TRIP({ PG8_MMA(0, 0, At, B0); PG8_MMA(0, 1, At, B1); }, { PG8_MMA(1, 0, At, B0); PG8_MMA(1, 1, At, B1); })
        } else {
            int t = 0;
            for (; 2 * t < nt; t += 2) PG8_TRIP({ PG8_MMA(0, 0, At, B0); }, { PG8_MMA(1, 1, At, B1); })
            for (; t < nt; t += 2) PG8_TRIP({ PG8_MMA(0, 1, At, B1); }, { PG8_MMA(1, 0, At, B0); })
        }
#undef PG8_TRIP
        if (wr == 0) PG8_BAR;
        E(acc, cur, wr, wc, fr, fq);
        if (!has_next) break;
#pragma unroll
        for (int a = 0; a < 2; ++a)
#pragma unroll
            for (int b = 0; b < 2; ++b)
#pragma unroll
                for (int m = 0; m < 4; ++m)
#pragma unroll
                    for (int n = 0; n < 2; ++n) acc[a][b][m][n] = (f32x4){0.f, 0.f, 0.f, 0.f};
        cur = nxt; cA = nA; cB = nB; ++ui;
        if (wr == 1) PG8_BAR;
    }
    PG8_WAIT_V(0);
    PG8_BAR;
#undef PG8_SA
#undef PG8_SB
#undef PG8_STAGE
#undef PG8_LDA
#undef PG8_LDB
#undef PG8_MMA
#undef PG8_WAIT_V
#undef PG8_WAIT_L
#undef PG8_BAR
#undef PG8_SCHED
}
}

struct SchedGrid {
    int nM, nN, G, c, pm0; const char* A; const char* B; size_t ta, tb;
    __device__ __forceinline__ size_t hstep_b(unsigned ldb) const { return (size_t)128 * ldb; }
    __device__ __forceinline__ bool next(int i, pg8::Unit& u) const {
        const long L = (long)i * G + c; if (L >= (long)nM * nN) return false;
        int pm, pn; pg8::tile_of((int)L, nM, nN, pm, pn); pm += pm0;
        u.pm = pm; u.pn = pn; u.e = 0; u.aux = 0; u.a = A + (size_t)pm * ta; u.b = B + (size_t)pn * tb; return true;
    }
    __device__ __forceinline__ void aoff(const pg8::Unit&, const int (&R)[2], const int (&C)[2], unsigned lda, unsigned (&vo)[2][2]) const {
#pragma unroll
        for (int h = 0; h < 2; ++h)
#pragma unroll
            for (int i = 0; i < 2; ++i) vo[h][i] = (unsigned)(h * 128 + R[i]) * lda + (unsigned)C[i] * 2u; }
};
struct SchedQuad {
    int nM, nN, G, c, tm0; const char* A; const char* B;
    __device__ __forceinline__ size_t hstep_b(unsigned) const { return (size_t)1024 * 2048; }
    __device__ __forceinline__ bool next(int i, pg8::Unit& u) const {
        const long L = (long)i * G + c; if (L >= (long)nM * nN) return false;
        int tm, tn; pg8::tile_of((int)L, nM, nN, tm, tn); tm += tm0;
        u.pm = tm; u.pn = tn; u.e = 0; u.aux = 0; u.a = A + (size_t)tm * 128 * 4096; u.b = B + (size_t)tn * 128 * 2048; return true;
    }
    __device__ __forceinline__ void aoff(const pg8::Unit&, const int (&R)[2], const int (&C)[2], unsigned lda, unsigned (&vo)[2][2]) const {
#pragma unroll
        for (int h = 0; h < 2; ++h)
#pragma unroll
            for (int i = 0; i < 2; ++i) vo[h][i] = (unsigned)R[i] * lda + (unsigned)(h * 1024 + C[i]) * 2u; }
};
__device__ __forceinline__ bool moe_unit(int i, int c, int G, int nN, int total, int& mtg, int& pn) {
    const int per = G >> 3, x = c & 7, r = c >> 3;
    if ((G & 7) != 0 || r >= per) { const long L = (long)i * G + c; mtg = (int)(L / nN); pn = (int)(L % nN); return mtg < total; }
    const int n = i * per + r; mtg = x + 8 * (n / nN); pn = n % nN; return mtg < total;
}
struct SchedMoe {
    const LAS int* tstart; const LAS unsigned short* toks; int nN, G, c; const char* A; const char* B; size_t ta, tb, eb;
    __device__ __forceinline__ size_t hstep_b(unsigned ldb) const { return (size_t)128 * ldb; }
    __device__ __forceinline__ bool next(int i, pg8::Unit& u) const {
        const int total = tstart[32]; int mtg, pn;
        if (!moe_unit(i, c, G, nN, total, mtg, pn)) return false;
        int e = 0;
#pragma unroll 1
        for (int k = 1; k < 32; ++k) e += (tstart[k] <= mtg) ? 1 : 0;
        u.pm = mtg; u.pn = pn; u.e = e; u.aux = (mtg - tstart[e]) | (i << 16);
        u.a = A + (size_t)mtg * ta; u.b = B + (size_t)e * eb + (size_t)pn * tb; return true;
    }
    __device__ __forceinline__ void aoff(const pg8::Unit& u, const int (&R)[2], const int (&C)[2], unsigned lda, unsigned (&vo)[2][2]) const {
        const int ord = u.aux >> 16;
#pragma unroll
        for (int h = 0; h < 2; ++h)
#pragma unroll
            for (int i = 0; i < 2; ++i) { const unsigned row = toks ? (unsigned)toks[ord * 256 + h * 128 + R[i]] : (unsigned)(h * 128 + R[i]); vo[h][i] = row * lda + (unsigned)C[i] * 2u; }
    }
};

struct EpiProj {
    static constexpr bool PERM = true;
    bf16_t* O; const float* rcos; const float* rsin; unsigned char* g8;
    __device__ __forceinline__ void operator()(const f32x4 (&acc)[2][2][4][2], const pg8::Unit& u, int wr, int wc, int fr, int fq) const {
        const int row0 = u.pm * 256 + wr * 64 + fr, col0 = u.pn * 256 + wc * 32 + 8 * fq;
        if (u.pn >= C_MG / 256) {
#pragma unroll
            for (int ai = 0; ai < 2; ++ai)
#pragma unroll
                for (int m = 0; m < 4; ++m) {
                    unsigned char* rowp = g8 + (size_t)(row0 + ai * 128 + m * 16) * 4096 + (u.pn - C_MG / 256) * 256 + wc * 64 + fq * 16;
                    u32x4 w4;
#pragma unroll
                    for (int bj = 0; bj < 2; ++bj) {
                        unsigned q[8];
#pragma unroll
                        for (int n = 0; n < 2; ++n) {
                            const f32x4 tt = acc[ai][bj][m][n] * -1.4426950408889634f; f32x4 ee, rr;
#pragma unroll
                            for (int j = 0; j < 4; ++j) ee[j] = __builtin_amdgcn_exp2f(tt[j]);
                            ee = ee + 1.0f;
#pragma unroll
                            for (int j = 0; j < 4; ++j) rr[j] = __builtin_amdgcn_rcpf(ee[j]);
                            rr = rr * 255.0f + 0.5f;
#pragma unroll
                            for (int j = 0; j < 4; ++j) q[4 * n + j] = (unsigned)rr[j]; }
                        const unsigned wx = q[0] | (q[1] << 8) | (q[2] << 16) | (q[3] << 24), wy = q[4] | (q[5] << 8) | (q[6] << 16) | (q[7] << 24);
                        if (bj == 0) { w4.x = wx; w4.y = wy; } else { w4.z = wx; w4.w = wy; }
                    }
                    *(u32x4*)rowp = w4;
                }
            return;
        }
        const bool qk = (u.pn >= 4) && (u.pn < 8) && (u.pm >= 16);
        const bool isq = (u.pn == 4) || (u.pn == 5);
        const float sgn = (fq < 2) ? -1.f : 1.f;
#pragma unroll
        for (int ai = 0; ai < 2; ++ai)
#pragma unroll
            for (int m = 0; m < 4; ++m) {
                const int row = row0 + ai * 128 + m * 16;
                f32x4 c0 = {1.f, 1.f, 1.f, 1.f}, c1 = c0, s0 = {0.f, 0.f, 0.f, 0.f}, s1 = s0;
                if (qk) { const int t = (row - NCTX) & (SEQ - 1); const int p = (wc & 1) ? (t & 63) : (t >> 6); const int f0 = p * 16 + 8 * (fq & 1);
                    c0 = *(const f32x4*)(rcos + f0); c1 = *(const f32x4*)(rcos + f0 + 4); s0 = *(const f32x4*)(rsin + f0); s1 = *(const f32x4*)(rsin + f0 + 4); }
                bf16_t* rowp = O + (size_t)row * PW + col0;
#pragma unroll
                for (int bj = 0; bj < 2; ++bj) {
                    f32x4 v0 = acc[ai][bj][m][0], v1 = acc[ai][bj][m][1];
                    if (qk) {
                        f32x4 p0, p1;
#pragma unroll
                        for (int j = 0; j < 4; ++j) { p0[j] = shx(v0[j], 32, fq * 16 + fr); p1[j] = shx(v1[j], 32, fq * 16 + fr); }
                        v0 = v0 * c0 + (p0 * s0) * sgn; v1 = v1 * c1 + (p1 * s1) * sgn;
                    }
                    if (isq) { v0 = v0 * QSCALE; v1 = v1 * QSCALE; }
                    u32x4 w; w.x = cvt_pk_bf16(v0[0], v0[1]); w.y = cvt_pk_bf16(v0[2], v0[3]); w.z = cvt_pk_bf16(v1[0], v1[1]); w.w = cvt_pk_bf16(v1[2], v1[3]);
                    *(u32x4*)(rowp + bj * 128) = w;
                }
                __builtin_amdgcn_sched_barrier(0);
            }
    }
};
struct EpiQuad {
    static constexpr bool PERM = false;
    const unsigned char* g8; bf16_t* mout;
    __device__ __forceinline__ void operator()(const f32x4 (&acc)[2][2][4][2], const pg8::Unit& u, int wr, int wc, int fr, int fq) const {
        const int row0 = u.pm * 128 + wr * 64 + fr, col0 = u.pn * 128 + wc * 32 + 4 * fq;
        const int gcol = (u.pn >> 1) * 256 + wc * 64 + (fq >> 1) * 16 + (u.pn & 1) * 8 + (fq & 1) * 4;
#pragma unroll
        for (int mh = 0; mh < 2; ++mh) {
            unsigned g4[2][2][4];
#pragma unroll
            for (int mm = 0; mm < 2; ++mm)
#pragma unroll
                for (int n = 0; n < 2; ++n)
#pragma unroll
                    for (int br = 0; br < 4; ++br) g4[mm][n][br] = *(const unsigned*)(g8 + (size_t)(row0 + (2 * mh + mm) * 16) * 4096 + gcol + n * 32 + br * 1024);
            asm volatile("" ::: "memory");
#pragma unroll
            for (int mm = 0; mm < 2; ++mm) {
                const int m = 2 * mh + mm, row = row0 + m * 16;
#pragma unroll
                for (int n = 0; n < 2; ++n) {
                    const int col = col0 + n * 16;
                    f32x4 v = {0.f, 0.f, 0.f, 0.f};
#pragma unroll
                    for (int br = 0; br < 4; ++br) {
                        const f32x4 p = (br == 0) ? acc[0][0][m][n] : (br == 1) ? acc[1][1][m][n] : (br == 2) ? acc[0][1][m][n] : acc[1][0][m][n];
                        const unsigned gw = g4[mm][n][br];
                        f32x4 g; g[0] = (float)(gw & 255u); g[1] = (float)((gw >> 8) & 255u); g[2] = (float)((gw >> 16) & 255u); g[3] = (float)(gw >> 24);
                        v += g * p;
                    }
                    v = v * (1.0f / 255.0f);
                    u32x2 w; w.x = cvt_pk_bf16(v[0], v[1]); w.y = cvt_pk_bf16(v[2], v[3]); *(u32x2*)(mout + (size_t)row * 1024 + col) = w;
                }
            }
        }
    }
};
struct EpiOut {
    static constexpr bool PERM = true;
    bf16_t* yb; const float* mod;
    __device__ __forceinline__ void operator()(const f32x4 (&acc)[2][2][4][2], const pg8::Unit& u, int wr, int wc, int fr, int fq) const {
        const int row0 = u.pm * 256 + wr * 64 + fr, col0 = u.pn * 256 + wc * 32 + 8 * fq;
        const int mr = (u.pm < 16) ? 16 : ((u.pm - 16) >> 3);
        const float* gp = mod + (size_t)mr * 6144 + 2048 + col0;
        f32x4 g[2][2];
#pragma unroll
        for (int bj = 0; bj < 2; ++bj) { g[bj][0] = *(const f32x4*)(gp + bj * 128); g[bj][1] = *(const f32x4*)(gp + bj * 128 + 4); }
#pragma unroll
        for (int ai = 0; ai < 2; ++ai)
#pragma unroll
            for (int m = 0; m < 4; ++m) {
                bf16_t* rowp = yb + (size_t)(row0 + ai * 128 + m * 16) * 1024 + col0;
#pragma unroll
                for (int bj = 0; bj < 2; ++bj) { const f32x4 v0 = acc[ai][bj][m][0] * g[bj][0], v1 = acc[ai][bj][m][1] * g[bj][1];
                    u32x4 w; w.x = cvt_pk_bf16(v0[0], v0[1]); w.y = cvt_pk_bf16(v0[2], v0[3]); w.z = cvt_pk_bf16(v1[0], v1[1]); w.w = cvt_pk_bf16(v1[2], v1[3]);
                    *(u32x4*)(rowp + bj * 128) = w; }
            }
    }
};
struct EpiGU {
    static constexpr bool PERM = true;
    bf16_t* hid; const float* bgu;
    __device__ __forceinline__ void operator()(const f32x4 (&acc)[2][2][4][2], const pg8::Unit& u, int wr, int wc, int fr, int fq) const {
        const int row0 = u.pm * 256 + wr * 64 + fr, hc0 = u.pn * 128 + wc * 32 + 8 * fq;
        const float* bp = bgu + (size_t)u.e * 2048 + hc0;
        const f32x4 bg0 = *(const f32x4*)bp, bg1 = *(const f32x4*)(bp + 4), bu0 = *(const f32x4*)(bp + 1024), bu1 = *(const f32x4*)(bp + 1028);
#pragma unroll
        for (int ai = 0; ai < 2; ++ai)
#pragma unroll
            for (int m = 0; m < 4; ++m) {
                const int row = row0 + ai * 128 + m * 16;
                f32x4 o[2];
#pragma unroll
                for (int n = 0; n < 2; ++n) {
                    const f32x4 g = acc[ai][0][m][n] + (n ? bg1 : bg0), up = acc[ai][1][m][n] + (n ? bu1 : bu0);
                    f32x4 gg, uu;
#pragma unroll
                    for (int j = 0; j < 4; ++j) { gg[j] = fminf(g[j], 7.f); uu[j] = fminf(fmaxf(up[j], -7.f), 7.f); }
                    const f32x4 tt = gg * (-1.702f * 1.4426950408889634f);
                    f32x4 ee;
#pragma unroll
                    for (int j = 0; j < 4; ++j) ee[j] = __builtin_amdgcn_exp2f(tt[j]);
                    ee = ee + 1.0f;
                    f32x4 rr;
#pragma unroll
                    for (int j = 0; j < 4; ++j) rr[j] = __builtin_amdgcn_rcpf(ee[j]);
                    o[n] = (uu + 1.0f) * (gg * rr);
                }
                u32x4 w; w.x = cvt_pk_bf16(o[0][0], o[0][1]); w.y = cvt_pk_bf16(o[0][2], o[0][3]); w.z = cvt_pk_bf16(o[1][0], o[1][1]); w.w = cvt_pk_bf16(o[1][2], o[1][3]);
                *(u32x4*)(hid + (size_t)row * 1024 + hc0) = w;
            }
    }
};
struct EpiDown {
    static constexpr bool PERM = true;
    unsigned char* y2; const float* bd; const int* elist; const unsigned* ecnt;
    __device__ __forceinline__ void operator()(const f32x4 (&acc)[2][2][4][2], const pg8::Unit& u, int wr, int wc, int fr, int fq) const {
        const int lr0 = wr * 64 + fr, col0 = u.pn * 256 + wc * 32 + 8 * fq;
        const int cnt = (int)ecnt[u.e * 64]; const int pos0 = (u.aux & 0xffff) * 256;
        const float* bp = bd + (size_t)u.e * 1024 + col0;
        f32x4 b[2][2];
#pragma unroll
        for (int bj = 0; bj < 2; ++bj) { b[bj][0] = *(const f32x4*)(bp + bj * 128); b[bj][1] = *(const f32x4*)(bp + bj * 128 + 4); }
        int tk[2][4];
#pragma unroll
        for (int ai = 0; ai < 2; ++ai)
#pragma unroll
            for (int m = 0; m < 4; ++m) { const int pos = pos0 + lr0 + ai * 128 + m * 16; tk[ai][m] = elist[(size_t)u.e * ECAP + (pos < cnt ? pos : 0)]; }
        asm volatile("" ::: "memory");
#pragma unroll
        for (int ai = 0; ai < 2; ++ai)
#pragma unroll
            for (int m = 0; m < 4; ++m) {
                const int pos = pos0 + lr0 + ai * 128 + m * 16;
                if (pos < cnt) {
                    const int tok4 = tk[ai][m];
                    unsigned char* rowp = y2 + (size_t)tok4 * 1024 + col0;
#pragma unroll
                    for (int bj = 0; bj < 2; ++bj) {
                        const f32x4 v0 = acc[ai][bj][m][0] + b[bj][0], v1 = acc[ai][bj][m][1] + b[bj][1];
                        u32x2 w; int t0 = __builtin_amdgcn_cvt_pk_fp8_f32(v0[0], v0[1], 0, false); t0 = __builtin_amdgcn_cvt_pk_fp8_f32(v0[2], v0[3], t0, true);
                        int t1 = __builtin_amdgcn_cvt_pk_fp8_f32(v1[0], v1[1], 0, false); t1 = __builtin_amdgcn_cvt_pk_fp8_f32(v1[2], v1[3], t1, true);
                        w.x = (unsigned)t0; w.y = (unsigned)t1; *(u32x2*)(rowp + bj * 128) = w;
                    }
                }
            }
    }
};

#define LDS_WAIT() asm volatile("s_waitcnt lgkmcnt(0)" ::: "memory")
#define LDS_BARRIER() asm volatile("s_waitcnt lgkmcnt(0)\n\ts_barrier" ::: "memory")
__device__ __forceinline__ void tr_item(const float* W, int ldn, int K, bf16_t* WT, int k0, int n0s, int r0, LAS float* scr, int lane, int kd0 = 0) {
    const int l15 = lane & 15, l4 = lane >> 4;
    const float* src = W + (size_t)(k0 + l4) * ldn + n0s + 4 * l15;
    f32x4 v[16];
#pragma unroll
    for (int i = 0; i < 16; ++i) v[i] = *(const f32x4*)(src + (size_t)(4 * i) * ldn);
    asm volatile("" ::: "memory");
#pragma unroll
    for (int i = 0; i < 16; ++i) { LAS float* d = scr + (4 * l15) * 65 + 4 * i + l4; d[0] = v[i][0]; d[65] = v[i][1]; d[130] = v[i][2]; d[195] = v[i][3]; }
    LDS_WAIT(); asm volatile("" ::: "memory");
    const int c = lane & 7;
#pragma unroll
    for (int j = 0; j < 8; ++j) { const int n = (lane >> 3) + 8 * j; const LAS float* s = scr + n * 65 + 8 * c;
        u32x4 o; o.x = cvt_pk_bf16(s[0], s[1]); o.y = cvt_pk_bf16(s[2], s[3]); o.z = cvt_pk_bf16(s[4], s[5]); o.w = cvt_pk_bf16(s[6], s[7]);
        *(u32x4*)(WT + (size_t)(r0 + n) * K + kd0 + k0 + 8 * c) = o; }
    LDS_WAIT(); asm volatile("" ::: "memory");
}
__device__ __forceinline__ void p0_weights(Frame& F) {
    int tid_ = threadIdx.x; LAUNDER_V(tid_); const int lane_ = tid_ & 63, wave_ = __builtin_amdgcn_readfirstlane(tid_ >> 6); (void)lane_; (void)wave_;
    for (int task = F.bid; task < DEPTH * 4 * 16; task += F.G) {
        const int kb = task & 15, g = (task >> 4) & 3, li = task >> 6;
        LAS float* wl = (LAS float*)F.lds;
        LAS float* pl = wl + 64 * 129;
        const float* wsrc = F.in[6] + ((size_t)li * 1024 + kb * 64) * INW + C_PU + g * 128; const float* psrc = F.in[16] + (size_t)(li * 4 + g) * 128 * 128;
        f32x4 wv[4], pv[8];
#pragma unroll
        for (int i = 0; i < 4; ++i) wv[i] = *(const f32x4*)(wsrc + (size_t)((tid_ >> 5) + 16 * i) * INW + 4 * (tid_ & 31));
#pragma unroll
        for (int i = 0; i < 8; ++i) pv[i] = *(const f32x4*)(psrc + (size_t)(tid_ + 512 * i) * 4);
#pragma unroll
        for (int i = 0; i < 4; ++i) { LAS float* d = wl + ((tid_ >> 5) + 16 * i) * 129 + 4 * (tid_ & 31); d[0] = wv[i][0]; d[1] = wv[i][1]; d[2] = wv[i][2]; d[3] = wv[i][3]; }
#pragma unroll
        for (int i = 0; i < 8; ++i) *(LAS f32x4*)(pl + (tid_ + 512 * i) * 4) = pv[i];
        __syncthreads();
        const int k = tid_ & 63, eb = wave_;
        f32x4 a0 = {0.f, 0.f, 0.f, 0.f}, a1 = a0, a2 = a0, a3 = a0;
#pragma unroll 4
        for (int c = 0; c < 128; ++c) { const float w = wl[k * 129 + c]; const LAS f32x4* p = (const LAS f32x4*)(pl + c * 128 + eb * 16);
            a0 += p[0] * w; a1 += p[1] * w; a2 += p[2] * w; a3 += p[3] * w; }
        bf16_t* dst = WSP(bf16_t, WS_WIN) + ((size_t)li * PW + C_PU + g * 128 + eb * 16) * 1024 + kb * 64 + k;
#pragma unroll
        for (int j = 0; j < 4; ++j) { dst[(size_t)j * 1024] = f2bf(a0[j]); dst[(size_t)(4 + j) * 1024] = f2bf(a1[j]); dst[(size_t)(8 + j) * 1024] = f2bf(a2[j]); dst[(size_t)(12 + j) * 1024] = f2bf(a3[j]); }
        __syncthreads();
    }
    LAS float* scr = (LAS float*)(F.lds + wave_ * 16640);
    const int gw = F.bid * NWAVES + wave_, NGW = F.G * NWAVES, lane = lane_;
    constexpr int I_IN = 16 * (PW / 64), I_GU = 16 * 32, I_DN = 16 * 16, I_BR = 8 * 16, I_OUT = 16 * 16, I_RNN = 1;
    constexpr int N_IN = DEPTH * I_IN, N_GU = DEPTH * 32 * I_GU, N_DN = DEPTH * 32 * I_DN, N_BR = DEPTH * 4 * I_BR, N_OUT = DEPTH * I_OUT, N_RNN = DEPTH * 2 * 8 * I_RNN;
    constexpr int NITEMS = N_IN + N_GU + N_DN + N_BR + N_OUT + 2 * N_RNN;
    for (int it = gw; it < NITEMS; it += NGW) {
        int r = it;
        if (r < N_GU) { const int mat = r / I_GU, q = r % I_GU, kb = q / 32, rb = q % 32; const int r0 = rb * 64; const int pn = r0 >> 8, half = (r0 >> 7) & 1, jj = r0 & 127;
            tr_item(F.in[33] + (size_t)mat * 1024 * 2048, 2048, 1024, WSP(bf16_t, WS_WGU) + (size_t)mat * 2048 * 1024, kb * 64, half * 1024 + pn * 128 + jj, r0, scr, lane); continue; } r -= N_GU;
        if (r < N_DN) { const int mat = r / I_DN, q = r % I_DN, kb = q / 16, rb = q % 16;
            tr_item(F.in[35] + (size_t)mat * 1024 * 1024, 1024, 1024, WSP(bf16_t, WS_WD) + (size_t)mat * 1024 * 1024, kb * 64, rb * 64, rb * 64, scr, lane); continue; } r -= N_DN;
        if (r < N_IN) { const int mat = r / I_IN, q = r % I_IN, kb = q / (PW / 64), rb = q % (PW / 64); const int r0 = rb * 64;
            if (r0 >= C_PU && r0 < C_PU + 512) continue;
            tr_item(F.in[6] + (size_t)mat * 1024 * INW, INW, 1024, WSP(bf16_t, WS_WIN) + (size_t)mat * PW * 1024, kb * 64, r0 < C_MG ? r0 : r0 + 16, r0, scr, lane); continue; } r -= N_IN;
        if (r < N_BR) { const int mat = r / I_BR, q = r % I_BR, kb = q / 16, rb = q % 16;
            { const int lay = mat >> 2, br = mat & 3; const int hq = (br == 1 || br == 2) ? 1 : 0, sq = (br >= 2) ? 1 : 0;
              tr_item(F.in[25] + (size_t)mat * 512 * 1024, 1024, 1024, WSP(bf16_t, WS_WBR) + ((size_t)lay * 2 + hq) * 1024 * 1024, kb * 64, rb * 64, rb * 64, scr, lane, sq * 512); } continue; } r -= N_BR;
        if (r < N_OUT) { const int mat = r / I_OUT, q = r % I_OUT, kb = q / 16, rb = q % 16;
            tr_item(F.in[26] + (size_t)mat * 1024 * 1024, 1024, 1024, WSP(bf16_t, WS_WOUT) + (size_t)mat * 1024 * 1024, kb * 64, rb * 64, rb * 64, scr, lane); continue; } r -= N_OUT;
        {
            const int gate = r / N_RNN; r %= N_RNN; const int mat = r; const int ld = mat / 8, h = mat % 8;
            tr_item(F.in[gate ? 11 : 9] + (size_t)mat * 64 * 64, 64, 64, WSP(bf16_t, WS_RNNW) + ((size_t)(ld * 2 + gate) * 8 + h) * 64 * 64, 0, 0, 0, scr, lane);
        }
    }
    const int gt = F.bid * NTHREADS + tid_, NGT = F.G * NTHREADS;
    for (int i = gt; i < DEPTH * 16 * 1024; i += NGT) { const int li = i >> 14, j = (i >> 10) & 15, k = i & 1023; WSP(float, WS_WDT)[i] = F.in[6][((size_t)li * 1024 + k) * INW + C_MG + j]; }
    for (int i = gt; i < DEPTH * 32 * 1024; i += NGT) { const int li = i >> 15, e = (i >> 10) & 31, k = i & 1023; WSP(float, WS_ROUT)[i] = F.in[31][((size_t)li * 1024 + k) * 32 + e]; }
    for (int i = gt; i < 64 * 16; i += NGT) { const int p = i >> 4, f = i & 15; const float inv = powf(10000.0f, -(float)f / 16.0f); const float ang = (float)p * inv;
        WSP(float, WS_ROPE)[i] = cosf(ang); WSP(float, WS_ROPE)[1024 + i] = sinf(ang); }
}
__device__ __forceinline__ void p0_mod(Frame& F) {
    int tid_ = threadIdx.x; LAUNDER_V(tid_); const int lane_ = tid_ & 63, wave_ = __builtin_amdgcn_readfirstlane(tid_ >> 6); (void)lane_; (void)wave_;
    __syncthreads();
    LAS float* sc = (LAS float*)F.lds;
    LAS float* red = sc + 17440;
    for (int i = tid_; i < 17 * 1024; i += NTHREADS) { const int r = i >> 10, k = i & 1023; const float v = r < 16 ? F.in[1][r * 1024 + k] : F.in[3][k]; sc[r * 1025 + k] = siluf_(v); }
    __syncthreads();
    const int m = lane_ & 31, kk = lane_ >> 5;
    for (int cb = F.bid; cb < 256; cb += F.G) {
        const int li = cb >> 6, j0 = (cb & 63) * 96;
        f32x16 acc0, acc1, acc2;
#pragma unroll
        for (int j = 0; j < 16; ++j) { acc0[j] = 0.f; acc1[j] = 0.f; acc2[j] = 0.f; }
        const float* wp = F.in[4] + ((size_t)li * 1024 + wave_ * 128 + kk) * 6144 + j0 + m;
        const LAS float* ap = sc + (m < 17 ? m : 0) * 1025 + wave_ * 128 + kk;
#pragma unroll 1
        for (int kb = 0; kb < 64; kb += 16) {
            float w0[16], w1[16], w2[16], av[16];
#pragma unroll
            for (int i = 0; i < 16; ++i) { const float* p = wp + (size_t)(2 * (kb + i)) * 6144; w0[i] = p[0]; w1[i] = p[32]; w2[i] = p[64]; }
#pragma unroll
            for (int i = 0; i < 16; ++i) { const float a = ap[2 * (kb + i)]; av[i] = m < 17 ? a : 0.f; }
#pragma unroll
            for (int i = 0; i < 16; ++i) {
                acc0 = __builtin_amdgcn_mfma_f32_32x32x2f32(av[i], w0[i], acc0, 0, 0, 0);
                acc1 = __builtin_amdgcn_mfma_f32_32x32x2f32(av[i], w1[i], acc1, 0, 0, 0);
                acc2 = __builtin_amdgcn_mfma_f32_32x32x2f32(av[i], w2[i], acc2, 0, 0, 0); }
        }
        LAS float* rw = red + wave_ * (3 * 9 * 64) + lane_;
#pragma unroll
        for (int j = 0; j < 9; ++j) { rw[(0 * 9 + j) * 64] = acc0[j]; rw[(1 * 9 + j) * 64] = acc1[j]; rw[(2 * 9 + j) * 64] = acc2[j]; }
        __syncthreads();
        for (int o = tid_; o < 3 * 9 * 64; o += NTHREADS) { const int l = o & 63, j = (o >> 6) % 9, blk = (o >> 6) / 9; const int row = (j & 3) + 8 * (j >> 2) + 4 * (l >> 5), c2 = blk * 32 + (l & 31);
            if (row < 17) { float sacc = F.in[5][(size_t)li * 6144 + j0 + c2];
#pragma unroll
                for (int q = 0; q < 8; ++q) sacc += red[q * (3 * 9 * 64) + o];
                WSP(float, WS_MOD)[((size_t)li * 17 + row) * 6144 + j0 + c2] = sacc; } }
        __syncthreads();
    }
}

__device__ __forceinline__ void row_norm(f32x4 (&v)[4], float eps, int lane) {
    float s = 0.f;
#pragma unroll
    for (int j = 0; j < 4; ++j) s += (v[j][0] + v[j][1]) + (v[j][2] + v[j][3]);
    const float mean = wave_sum(s, lane) * (1.f / 1024.f); float q = 0.f;
#pragma unroll
    for (int j = 0; j < 4; ++j) { v[j] = v[j] - mean; q += (v[j][0] * v[j][0] + v[j][1] * v[j][1]) + (v[j][2] * v[j][2] + v[j][3] * v[j][3]); }
    const float rstd = __builtin_amdgcn_rsqf(wave_sum(q, lane) * (1.f / 1024.f) + eps);
#pragma unroll
    for (int j = 0; j < 4; ++j) v[j] = v[j] * rstd;
}
__device__ __forceinline__ int mod_row_of(int row) { return row < NCTX ? 16 : ((row - NCTX) >> 11); }
__device__ __forceinline__ void modulate_row(f32x4 (&v)[4], const float* modrow, int so, int lane) {
    row_norm(v, 1e-6f, lane);
#pragma unroll
    for (int j = 0; j < 4; ++j) { const f32x4 sh = *(const f32x4*)(modrow + so + lane * 4 + 256 * j), sc = *(const f32x4*)(modrow + so + 1024 + lane * 4 + 256 * j); v[j] = v[j] * (sc + 1.0f) + sh; }
}
__device__ __forceinline__ void store_row_bf16(bf16_t* p, const f32x4 (&v)[4], int lane) {
#pragma unroll
    for (int j = 0; j < 4; ++j) { u32x2 w; w.x = cvt_pk_bf16(v[j][0], v[j][1]); w.y = cvt_pk_bf16(v[j][2], v[j][3]); *(u32x2*)(p + lane * 4 + 256 * j) = w; }
}
__device__ __forceinline__ void dt_rows(const f32x4 (&hA)[4], const f32x4 (&hB)[4], const LAS float* wdt, float* dtA, float* dtB, int lane) {
    float part[32];
#pragma unroll
    for (int c = 0; c < 16; ++c) { f32x4 a = {0.f, 0.f, 0.f, 0.f}, b = a;
#pragma unroll
        for (int j = 0; j < 4; ++j) { const f32x4 w = *(const LAS f32x4*)(wdt + c * 1024 + lane * 4 + 256 * j); a += hA[j] * w; b += hB[j] * w; }
        part[c] = (a[0] + a[1]) + (a[2] + a[3]); part[16 + c] = (b[0] + b[1]) + (b[2] + b[3]); if ((c & 3) == 3) __builtin_amdgcn_sched_barrier(0); }
    const float v = bfly_reduce<32>(part, lane);
    const int idx = lane >> 1;
    if ((lane & 1) == 0) { if (idx < 16) dtA[idx] = v; else dtB[idx - 16] = v; }
}
__device__ __forceinline__ void p1_rows(Frame& F) {
    int tid_ = threadIdx.x; LAUNDER_V(tid_); const int lane_ = tid_ & 63, wave_ = __builtin_amdgcn_readfirstlane(tid_ >> 6); (void)lane_; (void)wave_;
    __syncthreads();
    LAS float* wdt = (LAS float*)F.lds;
    for (int i = tid_; i < 16 * 1024 / 4; i += NTHREADS) ((LAS f32x4*)wdt)[i] = ((const f32x4*)WSP(float, WS_WDT))[i];
    __syncthreads();
    const int gw = F.bid * NWAVES + wave_, NGW = F.G * NWAVES, lane = lane_;
    const float* mod = WSP(float, WS_MOD);
    for (int rp = gw; rp < NTOK / 2; rp += NGW) {
        const int rA = rp * 2, rB = rA + 1;
        const float* srcA = rA < NCTX ? F.in[2] + (size_t)rA * 1024 : F.in[0] + (size_t)(rA - NCTX) * 1024;
        const float* srcB = rB < NCTX ? F.in[2] + (size_t)rB * 1024 : F.in[0] + (size_t)(rB - NCTX) * 1024;
        f32x4 a[4], b[4];
#pragma unroll
        for (int j = 0; j < 4; ++j) { a[j] = ((const f32x4*)srcA)[lane + 64 * j]; b[j] = ((const f32x4*)srcB)[lane + 64 * j]; }
#pragma unroll
        for (int j = 0; j < 4; ++j) { ((f32x4*)(WSP(float, WS_XL) + (size_t)rA * 1024))[lane + 64 * j] = a[j]; ((f32x4*)(WSP(float, WS_XL) + (size_t)rB * 1024))[lane + 64 * j] = b[j]; }
        modulate_row(a, mod + (size_t)mod_row_of(rA) * 6144, 0, lane);
        modulate_row(b, mod + (size_t)mod_row_of(rB) * 6144, 0, lane);
        store_row_bf16(WSP(bf16_t, WS_H) + (size_t)rA * 1024, a, lane); store_row_bf16(WSP(bf16_t, WS_H) + (size_t)rB * 1024, b, lane);
        dt_rows(a, b, wdt, WSP(float, WS_DT) + (size_t)rA * 16, WSP(float, WS_DT) + (size_t)rB * 16, lane);
    }
}
__device__ __forceinline__ void p2b_rows(Frame& F, int li, int row_lo) {
    int tid_ = threadIdx.x; LAUNDER_V(tid_); const int lane_ = tid_ & 63, wave_ = __builtin_amdgcn_readfirstlane(tid_ >> 6); (void)lane_; (void)wave_;
    LAUNDER_S(li);
    const int gw = F.bid * NWAVES + wave_, NGW = F.G * NWAVES, lane = lane_;
    const bf16_t* proj = WSP(bf16_t, WS_PROJ); bf16_t* ys = WSP(bf16_t, WS_YS);
    const float* nw = F.in[24] + (size_t)li * 512 + lane * 8;
    const f32x4 nw0 = *(const f32x4*)nw, nw1 = *(const f32x4*)(nw + 4);
    const f32x4 pb0 = *(const f32x4*)(F.in[17] + (size_t)li * 512 + lane * 8), pb1 = *(const f32x4*)(F.in[17] + (size_t)li * 512 + lane * 8 + 4);
    const f32x4 ps0 = *(const f32x4*)(F.in[18] + (size_t)li * 512 + lane * 8), ps1 = *(const f32x4*)(F.in[18] + (size_t)li * 512 + lane * 8 + 4);
    const int pwin = 2 << (lane >> 4);
    for (int row = row_lo + gw; row < NTOK; row += NGW) {
        const size_t o5 = (size_t)row * 512 + lane * 8;
        const u32x4 hfv = *(const u32x4*)(WSP(bf16_t, WS_HF) + o5), hbv = *(const u32x4*)(WSP(bf16_t, WS_HB) + o5), yfv = *(const u32x4*)(WSP(bf16_t, WS_YF) + o5), ybv = *(const u32x4*)(WSP(bf16_t, WS_YB) + o5);
        const u32x4 rgv = *(const u32x4*)(proj + (size_t)row * PW + C_RG + lane * 8), zv = *(const u32x4*)(proj + (size_t)row * PW + C_Z + lane * 8);
        {
            const int L = row < NCTX ? CTXL : SEQ, segbase = row < NCTX ? (row & ~(CTXL - 1)) : NCTX + ((row - NCTX) & ~(SEQ - 1)), t = row - segbase;
            int lo = t - pwin / 2; lo = lo < 0 ? 0 : lo; int hi = t + pwin - 1 - pwin / 2; hi = hi > L - 1 ? L - 1 : hi;
            f32x4 s0 = {0.f, 0.f, 0.f, 0.f}, s1 = s0;
            u32x4 pv[16];
#pragma unroll
            for (int j = 0; j < 16; ++j) { int tj = t - 8 + j; tj = tj < 0 ? 0 : (tj > L - 1 ? L - 1 : tj); pv[j] = *(const u32x4*)(proj + (size_t)(segbase + tj) * PW + C_PU + lane * 8); }
            asm volatile("" ::: "memory");
#pragma unroll
            for (int j = 0; j < 16; ++j) { const int tj = t - 8 + j; const float mk = (tj >= lo && tj <= hi) ? 1.0f : 0.0f; const u32x4 v = pv[j];
                s0[0] += mk * lo_bf(v.x); s0[1] += mk * hi_bf(v.x); s0[2] += mk * lo_bf(v.y); s0[3] += mk * hi_bf(v.y); s1[0] += mk * lo_bf(v.z); s1[1] += mk * hi_bf(v.z); s1[2] += mk * lo_bf(v.w); s1[3] += mk * hi_bf(v.w); }
            const u32x4 sv = *(const u32x4*)(proj + (size_t)row * PW + C_PU + lane * 8);
            const float rc = __builtin_amdgcn_rcpf((float)(hi - lo + 1));
            f32x4 m0, m1; m0[0] = s0[0] * rc - lo_bf(sv.x); m0[1] = s0[1] * rc - hi_bf(sv.x); m0[2] = s0[2] * rc - lo_bf(sv.y); m0[3] = s0[3] * rc - hi_bf(sv.y);
            m1[0] = s1[0] * rc - lo_bf(sv.z); m1[1] = s1[1] * rc - hi_bf(sv.z); m1[2] = s1[2] * rc - lo_bf(sv.w); m1[3] = s1[3] * rc - hi_bf(sv.w);
            m0 = (m0 + pb0) * ps0; m1 = (m1 + pb1) * ps1;
            u32x4 w; w.x = cvt_pk_bf16(m0[0], m0[1]); w.y = cvt_pk_bf16(m0[2], m0[3]); w.z = cvt_pk_bf16(m1[0], m1[1]); w.w = cvt_pk_bf16(m1[2], m1[3]);
            *(u32x4*)(ys + (size_t)row * 2048 + 512 + lane * 8) = w;
        }
        {
            const f32x4 y0 = bf4lo_(hfv) + bf4lo_(hbv), y1 = bf4hi_(hfv) + bf4hi_(hbv);
            const f32x4 o0 = gelu4_(bf4lo_(rgv)) * y0, o1 = gelu4_(bf4hi_(rgv)) * y1;
            u32x4 w; w.x = cvt_pk_bf16(o0[0], o0[1]); w.y = cvt_pk_bf16(o0[2], o0[3]); w.z = cvt_pk_bf16(o1[0], o1[1]); w.w = cvt_pk_bf16(o1[2], o1[3]);
            *(u32x4*)(ys + (size_t)row * 2048 + lane * 8) = w;
        }
        {
            f32x4 g0 = (bf4lo_(yfv) + bf4lo_(ybv)) * silu4_(bf4lo_(zv)), g1 = (bf4hi_(yfv) + bf4hi_(ybv)) * silu4_(bf4hi_(zv));
            float ss = (g0[0] * g0[0] + g0[1] * g0[1]) + (g0[2] * g0[2] + g0[3] * g0[3]) + (g1[0] * g1[0] + g1[1] * g1[1]) + (g1[2] * g1[2] + g1[3] * g1[3]);
#pragma unroll
            for (int o = 1; o < 32; o <<= 1) ss += shx(ss, o, lane);
            const float r = __builtin_amdgcn_rsqf(ss * (1.f / 256.f) + 1e-5f);
            g0 = g0 * r * nw0; g1 = g1 * r * nw1;
            u32x4 w; w.x = cvt_pk_bf16(g0[0], g0[1]); w.y = cvt_pk_bf16(g0[2], g0[3]); w.z = cvt_pk_bf16(g1[0], g1[1]); w.w = cvt_pk_bf16(g1[2], g1[3]);
            *(u32x4*)(ys + (size_t)row * 2048 + 1536 + lane * 8) = w;
        }
    }
}
__device__ __forceinline__ void p5_rows(Frame& F, int li, int row_lo, bool dry) {
    int tid_ = threadIdx.x; LAUNDER_V(tid_); const int lane_ = tid_ & 63, wave_ = __builtin_amdgcn_readfirstlane(tid_ >> 6); (void)lane_; (void)wave_;
    LAUNDER_S(li);
    __syncthreads();
    LAS float* rw = (LAS float*)F.lds;
    LAS unsigned* hist = (LAS unsigned*)(F.lds + XTRA_OFF);
    LAS unsigned* basev = hist + 32;
    LAS unsigned* ent = hist + 64;
#pragma unroll 16
    for (int i = tid_; i < 32 * 1024 / 4; i += NTHREADS) ((LAS f32x4*)rw)[i] = ((const f32x4*)(WSP(float, WS_ROUT) + (size_t)li * 32 * 1024))[i];
    if (tid_ < 32) hist[tid_] = 0u;
    const int lane = lane_;
    const int nrows = NTOK - row_lo, per = (nrows / 2 + F.G - 1) / F.G;
    const int p_lo = F.bid * per, p_hi = (p_lo + per) < (nrows / 2) ? (p_lo + per) : (nrows / 2);
    const float* mod = WSP(float, WS_MOD) + (size_t)li * 17 * 6144;
    const float rb = F.in[32][li * 32 + (lane & 31)];
    unsigned* ecnt = WSP(unsigned, WS_CTL) + CW_ECNT + li * 32 * 64;
    LAS float* lgs = (LAS float*)(F.lds + XTRA_OFF + 4864);
    LAS float* mds = (LAS float*)(F.lds + XTRA2_OFF);
    const int mA = mod_row_of(row_lo + p_lo * 2) > 16 ? 16 : mod_row_of(row_lo + p_lo * 2), mB = mod_row_of(row_lo + (p_hi > p_lo ? p_hi * 2 - 1 : p_lo * 2)) > 16 ? 16 : mod_row_of(row_lo + (p_hi > p_lo ? p_hi * 2 - 1 : p_lo * 2));
    {   const int q = tid_ & 255; const float* src = (tid_ >> 8) ? F.in[28] + (size_t)li * 1024 : F.in[27] + (size_t)li * 1024;
        ((LAS f32x4*)lgs)[tid_] = ((const f32x4*)src)[q];
#pragma unroll
        for (int i = 0; i < 2; ++i) { const int idx = tid_ + 512 * i, sl = idx >> 9, q9 = idx & 511;
            ((LAS f32x4*)mds)[idx] = ((const f32x4*)(mod + (size_t)(sl ? mB : mA) * 6144 + 3072))[q9]; } }
    __syncthreads();
    const float* xl = WSP(float, WS_XL); const bf16_t* yb = WSP(bf16_t, WS_MACC);
    f32x4 ca[4], cb[4], na[4], nb[4]; u32x2 cya[4], cyb[4], nya[4], nyb[4];
#define P5_ISSUE(A_, B_, YA_, YB_, RP_) do { const int rA_ = row_lo + (RP_) * 2; _Pragma("unroll") for (int j = 0; j < 4; ++j) { A_[j] = ((const f32x4*)(xl + (size_t)rA_ * 1024))[lane + 64 * j]; B_[j] = ((const f32x4*)(xl + (size_t)(rA_ + 1) * 1024))[lane + 64 * j]; } \
        _Pragma("unroll") for (int j = 0; j < 4; ++j) { YA_[j] = *(const u32x2*)(yb + (size_t)rA_ * 1024 + lane * 4 + 256 * j); YB_[j] = *(const u32x2*)(yb + (size_t)(rA_ + 1) * 1024 + lane * 4 + 256 * j); } } while (0)
    int rp = p_lo + wave_;
    if (rp < p_hi) P5_ISSUE(ca, cb, cya, cyb, rp);
    for (; rp < p_hi; rp += NWAVES) {
        const int rA = row_lo + rp * 2, rB = rA + 1;
        float* xAo = (dry ? WSP(float, WS_HF) : WSP(float, WS_XL)) + (size_t)rA * 1024; float* xBo = (dry ? WSP(float, WS_HF) : WSP(float, WS_XL)) + (size_t)rB * 1024;
        bf16_t* hO = dry ? WSP(bf16_t, WS_XG) : WSP(bf16_t, WS_H);
        { const int rn = rp + NWAVES; const int rq = rn < p_hi ? rn : rp; P5_ISSUE(na, nb, nya, nyb, rq); }
        asm volatile("" ::: "memory");
        const LAS float* ms = mds + ((mod_row_of(rA) == mA) ? 0 : 2048);
        f32x4 a[4], b[4];
#pragma unroll
        for (int j = 0; j < 4; ++j) {
            const u32x2 ya = cya[j], yb2 = cyb[j];
            a[j] = ca[j] * DN_ALPHA + (f32x4){lo_bf(ya.x), hi_bf(ya.x), lo_bf(ya.y), hi_bf(ya.y)}; b[j] = cb[j] * DN_ALPHA + (f32x4){lo_bf(yb2.x), hi_bf(yb2.x), lo_bf(yb2.y), hi_bf(yb2.y)}; }
        row_norm(a, 1e-5f, lane); row_norm(b, 1e-5f, lane);
#pragma unroll
        for (int j = 0; j < 4; ++j) { const f32x4 g = *(const LAS f32x4*)(lgs + lane * 4 + 256 * j), bb = *(const LAS f32x4*)(lgs + 1024 + lane * 4 + 256 * j); a[j] = a[j] * g + bb; b[j] = b[j] * g + bb;
            ((f32x4*)xAo)[lane + 64 * j] = a[j]; ((f32x4*)xBo)[lane + 64 * j] = b[j]; }
        row_norm(a, 1e-6f, lane); row_norm(b, 1e-6f, lane);
#pragma unroll
        for (int j = 0; j < 4; ++j) { const f32x4 sh = *(const LAS f32x4*)(ms + lane * 4 + 256 * j), sc = *(const LAS f32x4*)(ms + 1024 + lane * 4 + 256 * j); a[j] = a[j] * (sc + 1.0f) + sh; b[j] = b[j] * (sc + 1.0f) + sh; }
        store_row_bf16(hO + (size_t)rA * 1024, a, lane); store_row_bf16(hO + (size_t)rB * 1024, b, lane);
#pragma unroll
        for (int j = 0; j < 4; ++j) { ca[j] = na[j]; cb[j] = nb[j]; cya[j] = nya[j]; cyb[j] = nyb[j]; }
        float res[2];
#pragma unroll
        for (int hf = 0; hf < 2; ++hf) {
            float part[32];
#pragma unroll
            for (int e = 0; e < 16; ++e) { f32x4 sa = {0.f, 0.f, 0.f, 0.f}, sb = sa;
#pragma unroll
                for (int j = 0; j < 4; ++j) { const f32x4 w = *(const LAS f32x4*)(rw + (hf * 16 + e) * 1024 + lane * 4 + 256 * j); sa += a[j] * w; sb += b[j] * w; }
                part[e] = (sa[0] + sa[1]) + (sa[2] + sa[3]); part[16 + e] = (sb[0] + sb[1]) + (sb[2] + sb[3]); if ((e & 3) == 3) __builtin_amdgcn_sched_barrier(0); }
            res[hf] = bfly_reduce<32>(part, lane);
            __builtin_amdgcn_sched_barrier(0);
        }
        const int srcl = (lane & 32) | ((lane & 15) << 1);
        const float r0 = shl_(res[0], srcl), r1 = shl_(res[1], srcl);
        float lv = ((lane & 16) ? r1 : r0) + rb;
        float selv[4]; int sele[4];
#pragma unroll
        for (int k = 0; k < 4; ++k) {
            float m = lv; int mi = lane & 31;
#pragma unroll
            for (int o = 16; o >= 1; o >>= 1) { const float om = shx(m, o, lane); const int oi = shxi(mi, o, lane); if (om > m || (om == m && oi < mi)) { m = om; mi = oi; } }
            selv[k] = m; sele[k] = mi; if ((lane & 31) == mi) lv = -INFINITY;
        }
        const float e1 = __expf(selv[1] - selv[0]), e2 = __expf(selv[2] - selv[0]), e3 = __expf(selv[3] - selv[0]); const float inv = __builtin_amdgcn_rcpf(1.0f + e1 + e2 + e3);
        const int k = lane & 31;
        if (k < 4) {
            const int row = (lane >> 5) ? rB : rA;
            const float pk = (k == 0 ? 1.0f : k == 1 ? e1 : k == 2 ? e2 : e3) * inv; const int ek = (k == 0 ? sele[0] : k == 1 ? sele[1] : k == 2 ? sele[2] : sele[3]);
            if (!dry) WSP(float, WS_EP)[(size_t)row * 4 + k] = pk;
            const unsigned lp = __hip_atomic_fetch_add(&hist[ek], 1u, __ATOMIC_RELAXED, __HIP_MEMORY_SCOPE_WORKGROUP);
            const int n = ((rp - p_lo) * 2 + (lane >> 5)) * 4 + k;
            ent[n * 2] = (unsigned)(row * 4 + k); ent[n * 2 + 1] = (unsigned)ek | (lp << 8);
        }
    }
    __syncthreads();
    if (dry) return;
    if (tid_ < 32) basev[tid_] = atomicAdd(&ecnt[tid_ * 64], hist[tid_]);
    __syncthreads();
    const int nent = (p_hi > p_lo ? (p_hi - p_lo) : 0) * 8;
    int* elist = WSP(int, WS_ELIST);
    for (int n = tid_; n < nent; n += NTHREADS) { const unsigned t4 = ent[n * 2], w = ent[n * 2 + 1]; const unsigned e = w & 255u, lp = w >> 8; elist[(size_t)e * ECAP + basev[e] + lp] = (int)t4; }
}
__device__ __forceinline__ void moe_tstart(Frame& F, int li, LAS int* tstart) {
    __syncthreads();
    int tid = threadIdx.x; LAUNDER_V(tid); LAUNDER_S(li);
    if (tid < 32) {
        const unsigned* ecnt = WSP(unsigned, WS_CTL) + CW_ECNT + li * 32 * 64;
        const int lane = tid;
        const int nt = ((int)__hip_atomic_load(ecnt + lane * 64, __ATOMIC_RELAXED, __HIP_MEMORY_SCOPE_AGENT) + 255) >> 8;
        int incl = nt;
#pragma unroll
        for (int o = 1; o < 32; o <<= 1) { const int t = __builtin_amdgcn_ds_bpermute(((lane - o) & 63) << 2, incl); incl += (lane >= o) ? t : 0; }
        tstart[lane] = incl - nt;
        if (lane == 31) tstart[32] = incl;
    }
    __syncthreads();
}
__device__ __forceinline__ void moe_toks(Frame& F, int li, const LAS int* tstart, LAS unsigned short* toks, int nN) {
    const unsigned* ecnt = WSP(unsigned, WS_CTL) + CW_ECNT + li * 32 * 64; const int* elist = WSP(int, WS_ELIST);
    int tid = threadIdx.x; LAUNDER_V(tid); LAUNDER_S(li);
    const int total = tstart[32];
    int tk[14]; int nu = 0;
#pragma unroll
    for (int j = 0; j < 14; ++j) {
        const int i = (tid >> 8) + 2 * j; int mtg, pn; tk[j] = 0;
        if (moe_unit(i, F.bid, F.G, nN, total, mtg, pn)) {
            int e = 0;
            for (int k = 1; k < 32; ++k) e += (tstart[k] <= mtg) ? 1 : 0;
            const int pos = (mtg - tstart[e]) * 256 + (tid & 255);
            const int cnt = ((tstart[e + 1] - tstart[e] - 1) == (mtg - tstart[e])) ? (int)ecnt[e * 64] : 0x7fffffff;
            tk[j] = elist[(size_t)e * ECAP + (pos < cnt ? pos : 0)] | (pos < cnt ? 0 : (int)0x80000000);
            nu = j + 1;
        }
    }
#pragma unroll
    for (int j = 0; j < 14; ++j) if (j < nu) { const int i = (tid >> 8) + 2 * j; toks[i * 256 + (tid & 255)] = (unsigned short)(tk[j] < 0 ? 0 : (tk[j] >> 2)); }
    __syncthreads();
}
struct P9Ld { unsigned yw[2][4][4]; f32x4 xv[2][4]; f32x4 pkv[2]; };
__device__ __forceinline__ void p9_issue(P9Ld& L, const unsigned char* y2, const float* xl, const float* ep, int rp, int lane) {
#pragma unroll
    for (int h = 0; h < 2; ++h) { const int row = rp * 2 + h; L.pkv[h] = *(const f32x4*)(ep + (size_t)row * 4);
#pragma unroll
        for (int j = 0; j < 4; ++j) { L.xv[h][j] = ((const f32x4*)(xl + (size_t)row * 1024))[lane + 64 * j];
#pragma unroll
            for (int k = 0; k < 4; ++k) L.yw[h][j][k] = *(const unsigned*)(y2 + ((size_t)row * 4 + k) * 1024 + lane * 4 + 256 * j); } }
}
__device__ __forceinline__ void p9_rows(Frame& F, int li, int row_lo, bool dry) {
    int tid_ = threadIdx.x; LAUNDER_V(tid_); const int lane_ = tid_ & 63, wave_ = __builtin_amdgcn_readfirstlane(tid_ >> 6); (void)lane_; (void)wave_;
    LAUNDER_S(li);
    __syncthreads();
    const bool lastl = (li == DEPTH - 1);
    LAS float* wdt = (LAS float*)F.lds;
    LAS float* lgs = (LAS float*)(F.lds + 65536);
    LAS float* mds = (LAS float*)(F.lds + 65536 + 8192);
    const int nrows = NTOK - row_lo, per = (nrows / 2 + F.G - 1) / F.G;
    const int p_lo = row_lo / 2 + F.bid * per, p_hi = (p_lo + per) < (NTOK / 2) ? (p_lo + per) : (NTOK / 2);
    const int mA = mod_row_of(p_lo * 2), mB = mod_row_of(p_hi > p_lo ? p_hi * 2 - 1 : p_lo * 2);
    const float* mod = WSP(float, WS_MOD) + (size_t)li * 17 * 6144;
    const float* modn = WSP(float, WS_MOD) + (size_t)(lastl ? li : li + 1) * 17 * 6144;
    if (!lastl) {
#pragma unroll 8
        for (int i = tid_; i < 16 * 1024 / 4; i += NTHREADS) ((LAS f32x4*)wdt)[i] = ((const f32x4*)(WSP(float, WS_WDT) + (size_t)(li + 1) * 16 * 1024))[i]; }
    {   const int q = tid_ & 255; const float* src = (tid_ >> 8) ? F.in[30] + (size_t)li * 1024 : F.in[29] + (size_t)li * 1024;
        ((LAS f32x4*)lgs)[tid_] = ((const f32x4*)src)[q];
#pragma unroll
        for (int i = 0; i < 3; ++i) { const int idx = tid_ + 512 * i, sl = idx / 768, c = (idx % 768) >> 8, q4 = idx & 255; const int mr = sl ? mB : mA;
            const float* sp = (c == 0) ? mod + (size_t)mr * 6144 + 5120 : modn + (size_t)mr * 6144 + (c - 1) * 1024;
            ((LAS f32x4*)mds)[idx] = ((const f32x4*)sp)[q4]; } }
    __syncthreads();
    const int lane = lane_;
    const unsigned char* y2 = WSP(unsigned char, WS_Y2);
    const float* xl = WSP(float, WS_XL); const float* ep = WSP(float, WS_EP);
    P9Ld cur, nxt;
    int rp = p_lo + wave_;
    if (rp < p_hi) p9_issue(cur, y2, xl, ep, rp, lane);
    for (; rp < p_hi; rp += NWAVES) {
        { const int rn = rp + NWAVES; p9_issue(nxt, y2, xl, ep, rn < p_hi ? rn : rp, lane); }
        asm volatile("" ::: "memory");
        const LAS float* ms = mds + ((mod_row_of(rp * 2) == mA) ? 0 : 3 * 1024);
        f32x4 v[2][4];
#pragma unroll
        for (int h = 0; h < 2; ++h) {
#pragma unroll
            for (int j = 0; j < 4; ++j) { f32x4 f = {0.f, 0.f, 0.f, 0.f};
#pragma unroll
                for (int k = 0; k < 4; ++k) { const int w = (int)cur.yw[h][j][k]; const float pk = cur.pkv[h][k]; const f32x2 lo2 = __builtin_amdgcn_cvt_pk_f32_fp8(w, false), hi2 = __builtin_amdgcn_cvt_pk_f32_fp8(w, true);
                    f += (f32x4){lo2[0], lo2[1], hi2[0], hi2[1]} * pk; }
                const f32x4 g = *(const LAS f32x4*)(ms + lane * 4 + 256 * j);
                v[h][j] = cur.xv[h][j] * DN_ALPHA + g * f; } }
#pragma unroll
        for (int h = 0; h < 2; ++h) {
            const int row = rp * 2 + h;
            float* xw = (dry ? WSP(float, WS_HF) : WSP(float, WS_XL)) + (size_t)row * 1024;
            row_norm(v[h], 1e-5f, lane);
#pragma unroll
            for (int j = 0; j < 4; ++j) { const f32x4 g = *(const LAS f32x4*)(lgs + lane * 4 + 256 * j), bb = *(const LAS f32x4*)(lgs + 1024 + lane * 4 + 256 * j); v[h][j] = v[h][j] * g + bb; }
            if (lastl) {
#pragma unroll
                for (int j = 0; j < 4; ++j) ((f32x4*)((dry ? WSP(float, WS_HF) : F.out) + (size_t)(row - NCTX) * 1024))[lane + 64 * j] = v[h][j];
            } else {
#pragma unroll
                for (int j = 0; j < 4; ++j) ((f32x4*)xw)[lane + 64 * j] = v[h][j];
                row_norm(v[h], 1e-6f, lane);
#pragma unroll
                for (int j = 0; j < 4; ++j) { const f32x4 sh = *(const LAS f32x4*)(ms + 1024 + lane * 4 + 256 * j), sc = *(const LAS f32x4*)(ms + 2048 + lane * 4 + 256 * j); v[h][j] = v[h][j] * (sc + 1.0f) + sh; }
                store_row_bf16((dry ? WSP(bf16_t, WS_XG) : WSP(bf16_t, WS_H)) + (size_t)row * 1024, v[h], lane);
            }
        }
        if (!lastl) { float* dto = dry ? WSP(float, WS_YF) : WSP(float, WS_DT); dt_rows(v[0], v[1], wdt, dto + (size_t)(rp * 2) * 16, dto + (size_t)(rp * 2 + 1) * 16, lane); }
        cur = nxt;
    }
}

__device__ __forceinline__ void ssd_unit2(Frame& F, int li, int b, int hp, int dir, bool ctx_out) {
    constexpr int P72 = 72;
    constexpr int RP = 264;
    LAS bf16_t* RAW = (LAS bf16_t*)F.lds;
    LAS bf16_t* BN = (LAS bf16_t*)(F.lds + 35968);
    LAS bf16_t* CN = BN + 64 * P72;
    LAS bf16_t* BT = CN + 64 * P72;
    LAS bf16_t* XT = BT + 64 * P72;
    LAS bf16_t* XDT = XT + 2 * 64 * P72;
    LAS bf16_t* HS = XDT + 2 * 64 * P72;
    LAS float* CUM = (LAS float*)(HS + 2 * 64 * P72);
    LAS float* DTS = CUM + 128; LAS float* RDT = DTS + 128; LAS float* ED = RDT + 128; LAS float* TOT = ED + 128;
    LAS float* CW = TOT + 8;
    int tid = threadIdx.x; LAUNDER_V(tid); LAUNDER_S(li);
    const int lane = tid & 63, w = __builtin_amdgcn_readfirstlane(tid >> 6), r32 = lane & 31, hh = lane >> 5;
    const int hsel = w >> 2, pt = (w >> 1) & 1, lt = w & 1, g = hp >> 1;
    const int hd = hp * 2 + hsel;
    const bf16_t* proj = WSP(bf16_t, WS_PROJ); const float* dtp = WSP(float, WS_DT);
    bf16_t* yd = dir ? WSP(bf16_t, WS_YB) : WSP(bf16_t, WS_YF);
    __syncthreads();
    for (int i = tid; i < 5 * 256; i += NTHREADS) { const int k = i >> 8, ch = i & 255; const int gc = ch < 128 ? hp * 128 + ch : (ch < 192 ? 512 + g * 64 + (ch - 128) : 640 + g * 64 + (ch - 192));
        CW[i] = k < 4 ? F.in[19][((size_t)li * 4 + k) * 768 + gc] : F.in[20][(size_t)li * 768 + gc]; }
    for (int i = tid; i < 2 * 64 * P72 / 2; i += NTHREADS) ((LAS unsigned*)HS)[i] = 0u;
    const float av = -__expf(F.in[22][(li * 2 + dir) * 8 + hd]) * 1.4426950408889634f, dtb = F.in[21][(li * 2 + dir) * 8 + hd], dsk = F.in[23][(li * 2 + dir) * 8 + hd];
    const int g8 = tid & 31;
    const int rcol = g8 < 16 ? C_XBC + hp * 128 + g8 * 8 : (g8 < 24 ? C_XBC + 512 + g * 64 + (g8 - 16) * 8 : C_XBC + 640 + g * 64 + (g8 - 24) * 8);
    f32x16 Hreg = (f32x16){};
    u32x4 pre[5]; float predt = 0.f;
    auto chunk_pos = [&](int c, int& L, int& rowbase, int& t0) { const int seg = c >= 4, ci = seg ? c - 4 : c; L = seg ? SEQ : CTXL; rowbase = seg ? NCTX + b * SEQ : b * CTXL; const int nch = L / 64; t0 = (dir ? nch - 1 - ci : ci) * 64; };
    auto prefetch = [&](int c) {
        int L, rowbase, t0; chunk_pos(c, L, rowbase, t0);
#pragma unroll
        for (int i = 0; i < 5; ++i) { const int idx = tid + 512 * i; const int r = idx >> 5; int tr = t0 - 2 + r; tr = tr < 0 ? 0 : (tr > L - 1 ? L - 1 : tr);
            pre[i] = *(const u32x4*)(proj + (size_t)(rowbase + tr) * PW + rcol); }
        if ((w & 3) == 0) predt = dtp[(size_t)(rowbase + t0 + lane) * 16 + dir * 8 + hd];
    };
    prefetch(0);
#pragma unroll 1
    for (int c = 0; c < 36; ++c) {
        int L, rowbase, t0; chunk_pos(c, L, rowbase, t0);
#pragma unroll
        for (int i = 0; i < 5; ++i) { const int idx = tid + 512 * i; const int r = idx >> 5, tr = t0 - 2 + r; u32x4 v = pre[i]; if (tr < 0 || tr >= L) v = (u32x4){0u, 0u, 0u, 0u};
            if (idx < 68 * 32) *(LAS u32x4*)(RAW + r * RP + g8 * 8) = v; }
        if ((w & 3) == 0) {
            const float dt = softplusf_(predt + dtb); const float a = dt * av;
            float cs = a;
#pragma unroll
            for (int o = 1; o < 64; o <<= 1) { const int src = dir ? lane + o : lane - o; const float t = shl_(cs, src & 63); const bool ok = dir ? (lane + o < 64) : (lane >= o); cs += ok ? t : 0.f; }
            const float cend = shl_(cs, dir ? 0 : 63);
            CUM[hsel * 64 + lane] = cs; DTS[hsel * 64 + lane] = dt; RDT[hsel * 64 + lane] = 1.0f / dt; ED[hsel * 64 + lane] = exp2f(cend - cs);
            if (lane == 0) TOT[hsel] = exp2f(cend);
        }
        {
            LAS bf16_t* hq = HS + hsel * 64 * P72 + 32 * lt + r32;
#pragma unroll
            for (int r = 0; r < 16; ++r) hq[(32 * pt + (r & 3) + 8 * (r >> 2) + 4 * hh) * P72] = f2bf(Hreg[r]);
        }
        LDS_BARRIER();
        if (c + 1 < 36) prefetch(c + 1);
#pragma unroll
        for (int i = 0; i < 4; ++i) {
            const int tt = lane, gs = w + 8 * i;
            f32x4 a0 = *(const LAS f32x4*)(CW + 4 * 256 + gs * 8), a1 = *(const LAS f32x4*)(CW + 4 * 256 + gs * 8 + 4);
#pragma unroll
            for (int k = 0; k < 4; ++k) { const u32x4 rv = *(const LAS u32x4*)(RAW + (tt + k) * RP + gs * 8); const f32x4 w0 = *(const LAS f32x4*)(CW + k * 256 + gs * 8), w1 = *(const LAS f32x4*)(CW + k * 256 + gs * 8 + 4);
                a0[0] += w0[0] * lo_bf(rv.x); a0[1] += w0[1] * hi_bf(rv.x); a0[2] += w0[2] * lo_bf(rv.y); a0[3] += w0[3] * hi_bf(rv.y);
                a1[0] += w1[0] * lo_bf(rv.z); a1[1] += w1[1] * hi_bf(rv.z); a1[2] += w1[2] * lo_bf(rv.w); a1[3] += w1[3] * hi_bf(rv.w); }
            float u[8];
#pragma unroll
            for (int j = 0; j < 4; ++j) { u[j] = a0[j] * __builtin_amdgcn_rcpf(1.0f + __builtin_amdgcn_exp2f(-1.4426950408889634f * a0[j])); u[4 + j] = a1[j] * __builtin_amdgcn_rcpf(1.0f + __builtin_amdgcn_exp2f(-1.4426950408889634f * a1[j])); }
            if (gs < 16) {
                const int hs2 = gs >> 3; const float dtv = DTS[hs2 * 64 + tt], edv = ED[hs2 * 64 + tt];
                LAS bf16_t* xp = XT + (hs2 * 64 + (gs & 7) * 8) * P72 + tt; LAS bf16_t* xdp = XDT + (hs2 * 64 + (gs & 7) * 8) * P72 + tt;
#pragma unroll
                for (int j = 0; j < 8; ++j) { const float x = u[j] * dtv; xp[j * P72] = f2bf(x); xdp[j * P72] = f2bf(x * edv); }
            } else {
                u32x4 pk; pk.x = cvt_pk_bf16(u[0], u[1]); pk.y = cvt_pk_bf16(u[2], u[3]); pk.z = cvt_pk_bf16(u[4], u[5]); pk.w = cvt_pk_bf16(u[6], u[7]);
                if (gs < 24) { const int n0 = (gs - 16) * 8; *(LAS u32x4*)(BN + tt * P72 + n0) = pk;
#pragma unroll
                    for (int j = 0; j < 8; ++j) BT[(n0 + j) * P72 + tt] = f2bf(u[j]);
                } else { const int n0 = (gs - 24) * 8; *(LAS u32x4*)(CN + tt * P72 + n0) = pk; }
            }
        }
        LDS_BARRIER();
        {
            const int l = 32 * lt + r32;
            const float cl = CUM[hsel * 64 + l];
            bf16x8 cfr[4];
#pragma unroll
            for (int ks = 0; ks < 4; ++ks) cfr[ks] = *(const LAS bf16x8*)(CN + l * P72 + 16 * ks + 8 * hh);
            f32x16 acc2 = (f32x16){};
#pragma unroll
            for (int ks = 0; ks < 4; ++ks) { const bf16x8 hf = *(const LAS bf16x8*)(HS + (hsel * 64 + 32 * pt + r32) * P72 + 16 * ks + 8 * hh); acc2 = __builtin_amdgcn_mfma_f32_32x32x16_bf16(hf, cfr[ks], acc2, 0, 0, 0); }
            f32x16 acc1 = (f32x16){};
#pragma unroll
            for (int st = 0; st < 2; ++st) {
                const bool need = dir ? (st >= lt) : (st <= lt);
                if (need) {
                    f32x16 gt = (f32x16){};
#pragma unroll
                    for (int ks = 0; ks < 4; ++ks) { const bf16x8 bf = *(const LAS bf16x8*)(BN + (32 * st + r32) * P72 + 16 * ks + 8 * hh); gt = __builtin_amdgcn_mfma_f32_32x32x16_bf16(bf, cfr[ks], gt, 0, 0, 0); }
                    const float diag = dsk * RDT[hsel * 64 + l];
#pragma unroll
                    for (int r4 = 0; r4 < 4; ++r4) { const f32x4 csv = *(const LAS f32x4*)(CUM + hsel * 64 + 32 * st + 8 * r4 + 4 * hh);
#pragma unroll
                        for (int q = 0; q < 4; ++q) { const int sidx = 32 * st + 8 * r4 + 4 * hh + q; const float d = fminf(cl - csv[q], 0.f); const bool valid = dir ? (sidx >= l) : (sidx <= l);
                            float wv = valid ? gt[4 * r4 + q] * __builtin_amdgcn_exp2f(d) : 0.f; if (sidx == l) wv += diag; gt[4 * r4 + q] = wv; } }
#pragma unroll
                    for (int k2 = 0; k2 < 2; ++k2) {
                        u32x4 pw; pw.x = cvt_pk_bf16(gt[8 * k2 + 0], gt[8 * k2 + 1]); pw.y = cvt_pk_bf16(gt[8 * k2 + 2], gt[8 * k2 + 3]); pw.z = cvt_pk_bf16(gt[8 * k2 + 4], gt[8 * k2 + 5]); pw.w = cvt_pk_bf16(gt[8 * k2 + 6], gt[8 * k2 + 7]);
                        const LAS bf16_t* xq = XT + (hsel * 64 + 32 * pt + r32) * P72 + 32 * st + 16 * k2 + 4 * hh;
                        const u32x2 x0 = *(const LAS u32x2*)xq, x1 = *(const LAS u32x2*)(xq + 8);
                        const u32x4 xa = {x0.x, x0.y, x1.x, x1.y};
                        acc1 = __builtin_amdgcn_mfma_f32_32x32x16_bf16(__builtin_bit_cast(bf16x8, xa), __builtin_bit_cast(bf16x8, pw), acc1, 0, 0, 0);
                    }
                }
            }
            const float ecl = __builtin_amdgcn_exp2f(cl);
            if (c >= 4 || ctx_out) {
                bf16_t* yrow = yd + (size_t)(rowbase + t0 + l) * 512 + hd * 64 + 32 * pt + 4 * hh;
#pragma unroll
                for (int r4 = 0; r4 < 4; ++r4) { f32x4 o;
#pragma unroll
                    for (int q = 0; q < 4; ++q) o[q] = acc1[4 * r4 + q] + ecl * acc2[4 * r4 + q];
                    u32x2 ow; ow.x = cvt_pk_bf16(o[0], o[1]); ow.y = cvt_pk_bf16(o[2], o[3]); *(u32x2*)(yrow + 8 * r4) = ow; }
            }
            f32x16 acc3 = (f32x16){};
#pragma unroll
            for (int ks = 0; ks < 4; ++ks) { const bf16x8 xf = *(const LAS bf16x8*)(XDT + (hsel * 64 + 32 * pt + r32) * P72 + 16 * ks + 8 * hh); const bf16x8 bf = *(const LAS bf16x8*)(BT + (32 * lt + r32) * P72 + 16 * ks + 8 * hh);
                acc3 = __builtin_amdgcn_mfma_f32_32x32x16_bf16(xf, bf, acc3, 0, 0, 0); }
            const float tot = TOT[hsel];
#pragma unroll
            for (int r = 0; r < 16; ++r) Hreg[r] = tot * Hreg[r] + acc3[r];
        }
        LDS_BARRIER();
    }
}
__device__ __forceinline__ void rglru_unit(Frame& F, int li, int b, int blk, int dir, bool ctx_out) {
    LAS bf16_t* raw = (LAS bf16_t*)F.lds;
    constexpr int FP = 68;
    LAS float* u_s = (LAS float*)(F.lds + 8704);
    LAS bf16_t* ub_s = (LAS bf16_t*)(F.lds + 8704 + 17408);
    LAS float* a_s = (LAS float*)(F.lds + 8704 + 17408 + 9216);
    LAS float* b_s = a_s + 64 * FP; LAS float* h_s = b_s + 64 * FP; LAS float* sg_s = h_s + 64 * FP;
    int tid = threadIdx.x; LAUNDER_V(tid); LAUNDER_S(li);
    const int lane = tid & 63, w = __builtin_amdgcn_readfirstlane(tid >> 6), mt = w & 3, ntp = w >> 2;
    const bf16_t* proj = WSP(bf16_t, WS_PROJ);
    bf16_t* hd_ = dir ? WSP(bf16_t, WS_HB) : WSP(bf16_t, WS_HF);
    __syncthreads();
    f32x4 cwr[5][2];
#pragma unroll
    for (int k = 0; k < 5; ++k) { const float* cp = k < 4 ? F.in[7] + ((size_t)li * 4 + k) * 512 + blk * 64 + (tid & 7) * 8 : F.in[8] + (size_t)li * 512 + blk * 64 + (tid & 7) * 8; cwr[k][0] = *(const f32x4*)cp; cwr[k][1] = *(const f32x4*)(cp + 4); }
    bf16x8 Wf[2][2][2];
    f32x4 ba4[2], bx4[2], nl4[2];
#pragma unroll
    for (int ntl = 0; ntl < 2; ++ntl) {
        const int nt = ntp * 2 + ntl;
#pragma unroll
        for (int gate = 0; gate < 2; ++gate)
#pragma unroll
            for (int ks = 0; ks < 2; ++ks)
                Wf[gate][ntl][ks] = *(const bf16x8*)(WSP(bf16_t, WS_RNNW) + ((((size_t)(li * 2 + dir) * 2 + gate) * 8 + blk) * 64 + 16 * nt + (lane & 15)) * 64 + 32 * ks + 8 * (lane >> 4));
        const int ch = blk * 64 + 16 * nt + 4 * (lane >> 4);
        ba4[ntl] = *(const f32x4*)(F.in[10] + (size_t)(li * 2 + dir) * 512 + ch); bx4[ntl] = *(const f32x4*)(F.in[12] + (size_t)(li * 2 + dir) * 512 + ch);
        const f32x4 lm = *(const f32x4*)(F.in[13] + (size_t)(li * 2 + dir) * 512 + ch);
#pragma unroll
        for (int r = 0; r < 4; ++r) nl4[ntl][r] = -8.0f * softplusf_(-lm[r]);
    }
    float h = 0.f;
    u32x4 pre[2];
    auto chunk_pos = [&](int c, int& L, int& rowbase, int& t0) { const int seg = c >= 4, ci = seg ? c - 4 : c; L = seg ? SEQ : CTXL; rowbase = seg ? NCTX + b * SEQ : b * CTXL; const int nch = L / 64; t0 = (dir ? nch - 1 - ci : ci) * 64; };
    auto prefetch = [&](int c) { int L, rowbase, t0; chunk_pos(c, L, rowbase, t0);
#pragma unroll
        for (int i = 0; i < 2; ++i) { const int idx = tid + 512 * i; int tr = t0 - 2 + (idx >> 3); tr = tr < 0 ? 0 : (tr > L - 1 ? L - 1 : tr);
            pre[i] = *(const u32x4*)(proj + (size_t)(rowbase + tr) * PW + C_RX + blk * 64 + (idx & 7) * 8); } };
    prefetch(0);
    {
#pragma unroll 1
        for (int c = 0; c < 36; ++c) {
            int L, rowbase, t0; chunk_pos(c, L, rowbase, t0); const int seg = c >= 4;
            LDS_BARRIER();
#pragma unroll
            for (int i = 0; i < 2; ++i) { const int idx = tid + 512 * i; const int r = idx >> 3, tr = t0 - 2 + r; u32x4 v = pre[i]; if (tr < 0 || tr >= L) v = (u32x4){0u, 0u, 0u, 0u};
                if (idx < 67 * 8) *(LAS u32x4*)(raw + r * 64 + (idx & 7) * 8) = v; }
            LDS_BARRIER();
            if (c + 1 < 36) prefetch(c + 1);
            {   const int tt = tid >> 3, c8 = tid & 7;
                f32x4 a0 = cwr[4][0], a1 = cwr[4][1];
#pragma unroll
                for (int k = 0; k < 4; ++k) { const u32x4 rv = *(const LAS u32x4*)(raw + (tt + k) * 64 + c8 * 8);
                    a0[0] += cwr[k][0][0] * lo_bf(rv.x); a0[1] += cwr[k][0][1] * hi_bf(rv.x); a0[2] += cwr[k][0][2] * lo_bf(rv.y); a0[3] += cwr[k][0][3] * hi_bf(rv.y);
                    a1[0] += cwr[k][1][0] * lo_bf(rv.z); a1[1] += cwr[k][1][1] * hi_bf(rv.z); a1[2] += cwr[k][1][2] * lo_bf(rv.w); a1[3] += cwr[k][1][3] * hi_bf(rv.w); }
                *(LAS f32x4*)(u_s + tt * FP + c8 * 8) = a0; *(LAS f32x4*)(u_s + tt * FP + c8 * 8 + 4) = a1;
                u32x4 pk; pk.x = cvt_pk_bf16(a0[0], a0[1]); pk.y = cvt_pk_bf16(a0[2], a0[3]); pk.z = cvt_pk_bf16(a1[0], a1[1]); pk.w = cvt_pk_bf16(a1[2], a1[3]);
                *(LAS u32x4*)(ub_s + tt * 72 + c8 * 8) = pk; }
            LDS_BARRIER();
            {
                const bf16x8 uf0 = *(const LAS bf16x8*)(ub_s + (16 * mt + (lane & 15)) * 72 + 8 * (lane >> 4)), uf1 = *(const LAS bf16x8*)(ub_s + (16 * mt + (lane & 15)) * 72 + 32 + 8 * (lane >> 4));
                const int tt = 16 * mt + (lane & 15);
#pragma unroll
                for (int ntl = 0; ntl < 2; ++ntl) {
                    f32x4 aR = {0.f, 0.f, 0.f, 0.f}, aI = aR;
                    aR = __builtin_amdgcn_mfma_f32_16x16x32_bf16(Wf[0][ntl][0], uf0, aR, 0, 0, 0); aR = __builtin_amdgcn_mfma_f32_16x16x32_bf16(Wf[0][ntl][1], uf1, aR, 0, 0, 0);
                    aI = __builtin_amdgcn_mfma_f32_16x16x32_bf16(Wf[1][ntl][0], uf0, aI, 0, 0, 0); aI = __builtin_amdgcn_mfma_f32_16x16x32_bf16(Wf[1][ntl][1], uf1, aI, 0, 0, 0);
                    const int j0 = 16 * (ntp * 2 + ntl) + 4 * (lane >> 4);
                    const f32x4 uu = *(const LAS f32x4*)(u_s + tt * FP + j0);
                    f32x4 av, bv;
#pragma unroll
                    for (int r = 0; r < 4; ++r) { const float rr = __builtin_amdgcn_rcpf(1.0f + __builtin_amdgcn_exp2f(-1.4426950408889634f * (aR[r] + ba4[ntl][r]))), ig = __builtin_amdgcn_rcpf(1.0f + __builtin_amdgcn_exp2f(-1.4426950408889634f * (aI[r] + bx4[ntl][r])));
                        const float la = rr * nl4[ntl][r], x2 = 2.0f * la;
                        const float a = __builtin_amdgcn_exp2f(1.4426950408889634f * la);
                        const float om = x2 > -0.02f ? -x2 * (1.0f + 0.5f * x2 * (1.0f + 0.33333333f * x2)) : 1.0f - a * a;
                        av[r] = a; bv[r] = __builtin_amdgcn_sqrtf(om) * ig * uu[r]; }
                    *(LAS f32x4*)(a_s + tt * FP + j0) = av; *(LAS f32x4*)(b_s + tt * FP + j0) = bv;
                }
            }
            LDS_BARRIER();
            {
                float av[8], bv[8];
#pragma unroll
                for (int j = 0; j < 8; ++j) { const int sidx = 8 * w + j, tt = dir ? 63 - sidx : sidx; av[j] = a_s[tt * FP + lane]; bv[j] = b_s[tt * FP + lane]; }
                float P = 1.f, Hl = 0.f;
#pragma unroll
                for (int j = 0; j < 8; ++j) { P *= av[j]; Hl = av[j] * Hl + bv[j]; }
                sg_s[w * 64 + lane] = P; sg_s[512 + w * 64 + lane] = Hl;
                LDS_BARRIER();
                float cin = h, cc = h;
#pragma unroll
                for (int j = 0; j < 8; ++j) { if (j == w) cin = cc; cc = sg_s[j * 64 + lane] * cc + sg_s[512 + j * 64 + lane]; }
                h = cc;
#pragma unroll
                for (int j = 0; j < 8; ++j) { cin = av[j] * cin + bv[j]; const int sidx = 8 * w + j, tt = dir ? 63 - sidx : sidx; h_s[tt * FP + lane] = cin; }
            }
            LDS_BARRIER();
            if (seg || ctx_out) for (int i = tid; i < 64 * 16; i += NTHREADS) { const int tt = i >> 4, q4 = i & 15;
                const f32x4 hv = *(const LAS f32x4*)(h_s + tt * FP + q4 * 4); u32x2 hw; hw.x = cvt_pk_bf16(hv[0], hv[1]); hw.y = cvt_pk_bf16(hv[2], hv[3]);
                *(u32x2*)(hd_ + (size_t)(rowbase + t0 + tt) * 512 + blk * 64 + q4 * 4) = hw; }
        }
    }
}
typedef short v4i16_t __attribute__((ext_vector_type(4)));
__device__ __forceinline__ void glds16(const void* gsrc, unsigned lds_dst) { unsigned keep;
    asm volatile("s_mov_b32 %0, m0\n\ts_mov_b32 m0, %2\n\ts_nop 0\n\tglobal_load_lds_dwordx4 %1, off\n\ts_mov_b32 m0, %0" : "=&s"(keep) : "v"(gsrc), "s"(lds_dst) : "memory"); }
__device__ __forceinline__ void attn_unit(Frame& F, int li, int b, int h, int qt) {
    constexpr int KB = 64 * 64 * 2, VB = 64 * 128 * 2, BUF = KB + VB, NBUF = 4;
    int tid = threadIdx.x; LAUNDER_V(tid); LAUNDER_S(li);
    const int lane = tid & 63, w = __builtin_amdgcn_readfirstlane(tid >> 6), r32 = lane & 31, hh = lane >> 5;
    const bool isctx = (qt == 8);
    const int qrow0 = isctx ? b * CTXL : NCTX + b * SEQ + qt * 256;
    const int ntiles = isctx ? 4 : 36;
    const bf16_t* proj = WSP(bf16_t, WS_PROJ);
    float lam;
    { const float* lv = F.in[14] + (size_t)li * 256; const float s1 = wave_sum(lv[lane] * lv[64 + lane], lane), s2 = wave_sum(lv[128 + lane] * lv[192 + lane], lane); const float lam_init = 0.8f - 0.6f * __expf(-0.3f * (float)li); lam = __expf(s1) - __expf(s2) + lam_init; }
    const float lam_init = 0.8f - 0.6f * __expf(-0.3f * (float)li);
    f32x4* o0p = WSP(f32x4, WS_ATT) + ((size_t)F.bid * 512 + tid) * 16;
    const int vtr_base = ((lane >> 4) & 1) * 32 + (lane & 3) * 8 + (4 * hh + ((lane & 15) >> 2)) * 64;
    const unsigned lds0 = (unsigned)(uintptr_t)F.lds;
    const int dk_key = 8 * w + (lane >> 3), dk_col = ((lane & 7) ^ (dk_key & 7)) * 8;
    int dv_key[2], dv_col[2];
#pragma unroll
    for (int j = 0; j < 2; ++j) { const int sidx = 2 * (2 * w + j) + (lane >> 5); dv_key[j] = 8 * (sidx >> 2) + ((lane & 31) >> 2); dv_col[j] = 32 * (sidx & 3) + (lane & 3) * 8; }
    int koff[4];
#pragma unroll
    for (int ks = 0; ks < 4; ++ks) koff[ks] = ((2 * ks + hh) ^ (r32 & 7)) * 16;
#pragma unroll 1
    for (int c = 0; c < 2; ++c) {
        float m_run = 0.f;
        f32x16 o[4]; float lsum = 0.f;
        const bf16x8 ones = (bf16x8){0x3f80, 0x3f80, 0x3f80, 0x3f80, 0x3f80, 0x3f80, 0x3f80, 0x3f80};
#pragma unroll
        for (int et = 0; et < 4; ++et) o[et] = (f32x16){};
        auto dma = [&](int t) {
            const int krow = (t < 4) ? (b * CTXL + t * 64) : (NCTX + b * SEQ + (t - 4) * 64);
            const unsigned base = (unsigned)__builtin_amdgcn_readfirstlane((int)(lds0 + (unsigned)((t & (NBUF - 1)) * BUF + w * 1024)));
            glds16(proj + (size_t)(krow + dk_key) * PW + C_K + h * 128 + c * 64 + dk_col, base);
#pragma unroll
            for (int j = 0; j < 2; ++j) glds16(proj + (size_t)(krow + dv_key[j]) * PW + C_V + h * 128 + dv_col[j], base + (unsigned)(KB + w * 1024 + j * 1024));
        };
        __syncthreads();
        dma(0); dma(1); dma(2); dma(3);
        bf16x8 qf[4];
        { const bf16_t* qp = proj + (size_t)(qrow0 + 32 * w + r32) * PW + C_Q + h * 128 + c * 64 + 8 * hh;
#pragma unroll
          for (int ks = 0; ks < 4; ++ks) qf[ks] = *(const bf16x8*)(qp + 16 * ks); }
        asm volatile("s_waitcnt vmcnt(0)" : "+v"(qf[0]), "+v"(qf[1]), "+v"(qf[2]), "+v"(qf[3]) :: "memory");
        __syncthreads();
#pragma unroll 1
        for (int t = 0; t < ntiles; ++t) {
            const int bsel = t & (NBUF - 1);
            LAS unsigned char* kfp = F.lds + bsel * BUF + r32 * 128; LAS unsigned char* vfp = F.lds + bsel * BUF + KB + vtr_base;
            asm volatile("" : "+v"(kfp)); asm volatile("" : "+v"(vfp));
            f32x16 S[2];
            {   f32x16 negm;
#pragma unroll
                for (int r = 0; r < 16; ++r) negm[r] = -m_run;
                bf16x8 kf0[4], kf1[4];
#pragma unroll
                for (int ks = 0; ks < 4; ++ks) kf0[ks] = *(const LAS bf16x8*)(kfp + koff[ks]);
                __builtin_amdgcn_sched_barrier(0);
#pragma unroll
                for (int ks = 0; ks < 4; ++ks) kf1[ks] = *(const LAS bf16x8*)(kfp + koff[ks] + 4096);
                S[0] = negm;
#pragma unroll
                for (int ks = 0; ks < 4; ++ks) S[0] = __builtin_amdgcn_mfma_f32_32x32x16_bf16(kf0[ks], qf[ks], S[0], 0, 0, 0);
                __builtin_amdgcn_sched_barrier(0);
                S[1] = negm;
#pragma unroll
                for (int ks = 0; ks < 4; ++ks) S[1] = __builtin_amdgcn_mfma_f32_32x32x16_bf16(kf1[ks], qf[ks], S[1], 0, 0, 0); }
            float mx = fmaxf(S[0][0], S[1][0]);
#pragma unroll
            for (int r = 1; r < 16; ++r) mx = fmaxf(fmaxf(mx, S[0][r]), S[1][r]);
            mx = fmaxf(mx, shx(mx, 32, lane));
            if (t == 0 || __any(mx > 8.0f)) {
                const float dl = (t == 0) ? mx : fmaxf(mx, 0.f), alpha = (t == 0) ? 1.0f : __builtin_amdgcn_exp2f(-dl);
                m_run += dl;
#pragma unroll
                for (int kt = 0; kt < 2; ++kt)
#pragma unroll
                    for (int r = 0; r < 16; ++r) S[kt][r] -= dl;
#pragma unroll
                for (int et = 0; et < 4; ++et) o[et] = o[et] * alpha;
                lsum *= alpha;
            }
#pragma unroll
            for (int kt = 0; kt < 2; ++kt)
#pragma unroll
                for (int r = 0; r < 16; ++r) S[kt][r] = __builtin_amdgcn_exp2f(S[kt][r]);
            {   f32x2 rs = {0.f, 0.f};
#pragma unroll
                for (int kt = 0; kt < 2; ++kt)
#pragma unroll
                    for (int r = 0; r < 16; r += 2) rs += (f32x2){S[kt][r], S[kt][r + 1]};
                lsum += rs[0] + rs[1]; }
            bf16x8 pf[2][2];
#pragma unroll
            for (int kt = 0; kt < 2; ++kt)
#pragma unroll
                for (int s2 = 0; s2 < 2; ++s2) { u32x4 pw; pw.x = cvt_pk_bf16(S[kt][8 * s2 + 0], S[kt][8 * s2 + 1]); pw.y = cvt_pk_bf16(S[kt][8 * s2 + 2], S[kt][8 * s2 + 3]);
                    pw.z = cvt_pk_bf16(S[kt][8 * s2 + 4], S[kt][8 * s2 + 5]); pw.w = cvt_pk_bf16(S[kt][8 * s2 + 6], S[kt][8 * s2 + 7]); pf[kt][s2] = __builtin_bit_cast(bf16x8, pw); }
            {
                s16x4 va[2][4][2];
#define ATT_VLOAD(buf, et_) _Pragma("unroll") for (int kk = 0; kk < 4; ++kk) { LAS unsigned char* vp = vfp + ((2 * kk) * 4 + (et_)) * 512; \
                    va[buf][kk][0] = __builtin_bit_cast(s16x4, __builtin_amdgcn_ds_read_tr16_b64_v4i16((LAS v4i16_t*)vp)); va[buf][kk][1] = __builtin_bit_cast(s16x4, __builtin_amdgcn_ds_read_tr16_b64_v4i16((LAS v4i16_t*)(vp + 2048))); }
#define ATT_VMMA(buf, et_) __builtin_amdgcn_s_setprio(1); _Pragma("unroll") for (int kk = 0; kk < 4; ++kk) { const s16x4 lo = va[buf][kk][0], hi = va[buf][kk][1]; const bf16x8 vf = (bf16x8){lo[0], lo[1], lo[2], lo[3], hi[0], hi[1], hi[2], hi[3]}; \
                    o[et_] = __builtin_amdgcn_mfma_f32_32x32x16_bf16(vf, pf[kk >> 1][kk & 1], o[et_], 0, 0, 0); } __builtin_amdgcn_s_setprio(0);
#define ATT_SB __builtin_amdgcn_sched_barrier(0);
                ATT_VLOAD(0, 0) ATT_SB ATT_VLOAD(1, 1) ATT_SB
                ATT_VMMA(0, 0) ATT_SB ATT_VLOAD(0, 2) ATT_SB
                ATT_VMMA(1, 1) ATT_SB ATT_VLOAD(1, 3) ATT_SB
                ATT_VMMA(0, 2) ATT_SB
                ATT_VMMA(1, 3)
#undef ATT_SB
#undef ATT_VLOAD
#undef ATT_VMMA
            }
            if (t + 3 < ntiles) asm volatile("s_waitcnt vmcnt(6)" ::: "memory"); else if (t + 2 < ntiles) asm volatile("s_waitcnt vmcnt(3)" ::: "memory"); else asm volatile("s_waitcnt vmcnt(0)" ::: "memory");
            LDS_BARRIER();
            if (t + 4 < ntiles) dma(t + 4);
        }
        const float inv = __builtin_amdgcn_rcpf(lsum + shx(lsum, 32, lane));
        if (c == 0) {
#pragma unroll
            for (int et = 0; et < 4; ++et)
#pragma unroll
                for (int r4 = 0; r4 < 4; ++r4) o0p[et * 4 + r4] = (f32x4){o[et][4 * r4] * inv, o[et][4 * r4 + 1] * inv, o[et][4 * r4 + 2] * inv, o[et][4 * r4 + 3] * inv};
        } else {
            float ss = 0.f;
            const float li2 = lam * inv;
#pragma unroll
            for (int et = 0; et < 4; ++et) {
#pragma unroll
                for (int r4 = 0; r4 < 4; ++r4) { const f32x4 p0 = o0p[et * 4 + r4];
#pragma unroll
                    for (int q = 0; q < 4; ++q) { const float v = p0[q] - li2 * o[et][4 * r4 + q]; o[et][4 * r4 + q] = v; ss += v * v; } }
            }
            ss += shx(ss, 32, lane);
            const float rn = __builtin_amdgcn_rsqf(ss * (1.f / 128.f) + 1e-5f) * (1.0f - lam_init);
            LAS bf16_t* st = (LAS bf16_t*)(F.lds + w * (32 * 136 * 2));
#pragma unroll
            for (int et = 0; et < 4; ++et)
#pragma unroll
                for (int r = 0; r < 16; ++r) { const int e = 32 * et + (r & 3) + 8 * (r >> 2) + 4 * hh; st[r32 * 136 + e] = f2bf(o[et][r] * rn); }
            LDS_WAIT(); asm volatile("" ::: "memory");
            const float* sw = F.in[15] + (size_t)li * 128 + (lane & 15) * 8;
            const f32x4 sw0 = *(const f32x4*)sw, sw1 = *(const f32x4*)(sw + 4);
#pragma unroll
            for (int i = 0; i < 8; ++i) { const int idx = i * 64 + lane, q = idx >> 4, ch = idx & 15;
                const u32x4 v = *(const LAS u32x4*)(st + q * 136 + ch * 8);
                u32x4 ov; ov.x = cvt_pk_bf16(lo_bf(v.x) * sw0[0], hi_bf(v.x) * sw0[1]); ov.y = cvt_pk_bf16(lo_bf(v.y) * sw0[2], hi_bf(v.y) * sw0[3]);
                ov.z = cvt_pk_bf16(lo_bf(v.z) * sw1[0], hi_bf(v.z) * sw1[1]); ov.w = cvt_pk_bf16(lo_bf(v.w) * sw1[2], hi_bf(v.w) * sw1[3]);
                *(u32x4*)(WSP(bf16_t, WS_YS) + (size_t)(qrow0 + 32 * w + q) * 2048 + 1024 + h * 128 + ch * 8) = ov; }
        }
    }
}
__device__ __forceinline__ void p2_mixers(Frame& F, int li, int rep) {
    const bool need_ctx = (li < DEPTH - 1);
    const int n3 = need_ctx ? 960 : 896;
    volatile LAS int* qslot = (volatile LAS int*)(F.lds + MISC_OFF + 64);
    unsigned* qhead = WSP(unsigned, WS_CTL) + CW_QHEAD + (li * 2 + rep) * 64;
    for (;;) {
        __syncthreads();
        if (threadIdx.x == 0) *qslot = (int)__hip_atomic_fetch_add(qhead, 1u, __ATOMIC_RELAXED, __HIP_MEMORY_SCOPE_AGENT);
        __syncthreads();
        const int u = *qslot;
        if (u >= n3) break;
#ifndef TESTUNIT
#define TESTUNIT 15
#endif
#ifndef REPUNIT
#define REPUNIT 0
#endif
#define UREP(j) _Pragma("unroll 1") for (int urep_ = 0; urep_ < (((REPUNIT >> (j)) & 1) ? 2 : 1); ++urep_)
        if (u < 128) { if (TESTUNIT & 1) UREP(0) ssd_unit2(F, li, u >> 3, (u >> 1) & 3, u & 1, need_ctx); }
        else if (u < 640) { const int v = u - 128; if (TESTUNIT & 4) UREP(2) attn_unit(F, li, v >> 5, (v >> 3) & 3, v & 7); }
        else if (u < 896) { const int v = u - 640; if (TESTUNIT & 2) UREP(1) rglru_unit(F, li, v >> 4, (v >> 1) & 7, v & 1, need_ctx); }
        else { const int q = u - 896; if (TESTUNIT & 4) UREP(3) attn_unit(F, li, q >> 2, q & 3, 8); }
    }
}

__device__ __forceinline__ bool in_range_(int lo, int hi, int k) { asm volatile("" : "+s"(k)); return lo <= k && k < hi; }
struct Args { const float* in[37]; float* out; unsigned char* ws; int ph_lo, ph_hi; };
constexpr int NPH = 2 + DEPTH * 9;
__global__ void __launch_bounds__(NTHREADS, 2) fwd_kernel(Args args) {
    extern __shared__ __attribute__((aligned(16))) unsigned char lds_raw[];
    Frame F;
    F.lds = (LAS unsigned char*)lds_raw;
    F.G = gridDim.x; F.bid = blockIdx.x;
    F.in = args.in;
    F.out = args.out; F.ws = args.ws;
    volatile LAS unsigned* MISC = (volatile LAS unsigned*)(F.lds + MISC_OFF);
    if (threadIdx.x < 4) MISC[threadIdx.x] = 0u;
    __syncthreads();
    const int lo = args.ph_lo, hi = args.ph_hi;
    XcdBarrier bar; bar.bar = WSP(unsigned, WS_CTL) + CW_BAR; bar.x = 0; bar.st = nullptr;
    if (hi - lo > 1) bar = xcd_barrier_post(WSP(unsigned, WS_CTL) + CW_BAR, MISC);
#ifdef TESTPH
#define PH_EN(k) (((k) < 2 ? (k) : 2 + ((k) - 2) % 9) == TESTPH)
#else
#define PH_EN(k) true
#endif
#define IN(k) (PH_EN(k) && in_range_(lo, hi, (k)))
#ifndef BARX
#define BARX 0
#endif
#define SEAM(k) do { if (in_range_(lo, hi - 1, (k))) { xcd_barrier(bar); if (BARX) xcd_barrier(bar); } } while (0)
#ifndef REPMASK
#define REPMASK 0
#endif
#define NREP(j) (((REPMASK >> (j)) & 1) ? 2 : 1)
#define REPEAT(j) _Pragma("unroll 1") for (int rep_ = 0; rep_ < NREP(j); ++rep_)

#ifndef P0SEL
#define P0SEL 3
#endif
    if (IN(0)) { REPEAT(10) { if (rep_ == 0 || (P0SEL & 1)) p0_weights(F); if (rep_ == 0 || (P0SEL & 2)) p0_mod(F); } } SEAM(0);
    if (IN(1)) { REPEAT(11) { p1_rows(F); } } SEAM(1);
#pragma unroll 1
    for (int li = 0; li < DEPTH; ++li) {
        const int pb = 2 + li * 9;
        const bool need_ctx = (li < DEPTH - 1);
        const int pm0 = need_ctx ? 0 : 16;
        const int row_lo = pm0 * 256;
        if (IN(pb + 0)) REPEAT(0) {
            int li_ = li; LAUNDER_S(li_);
            SchedGrid S{NTOK / 256, PW / 256, F.G, F.bid, 0, (const char*)WSP(bf16_t, WS_H), (const char*)(WSP(bf16_t, WS_WIN) + (size_t)li_ * PW * 1024), (size_t)256 * 2048, (size_t)256 * 2048};
            EpiProj E{WSP(bf16_t, WS_PROJ), WSP(float, WS_ROPE), WSP(float, WS_ROPE) + 1024, WSP(unsigned char, WS_XG)};
            pg8::gemm_phase(F.lds, 1024, 2048u, 2048u, S, E);
        } SEAM(pb + 0);
        if (IN(pb + 1)) REPEAT(1) { p2_mixers(F, li, rep_); } SEAM(pb + 1);
        if (IN(pb + 2)) REPEAT(2) { p2b_rows(F, li, row_lo); } SEAM(pb + 2);
        if (IN(pb + 3)) REPEAT(3) {   int li_ = li; LAUNDER_S(li_);
            SchedQuad S{NTOK / 128 - 2 * pm0, 8, F.G, F.bid, 2 * pm0, (const char*)WSP(bf16_t, WS_YS), (const char*)(WSP(bf16_t, WS_WBR) + (size_t)li_ * 2 * 1024 * 1024)};
            EpiQuad E{WSP(unsigned char, WS_XG), WSP(bf16_t, WS_M)};
            pg8::gemm_phase<EpiQuad, SchedQuad, true>(F.lds, 1024, 4096u, 2048u, S, E);
        } SEAM(pb + 3);
        if (IN(pb + 4)) REPEAT(4) {
            int li_ = li; LAUNDER_S(li_); const bool dry = (NREP(4) == 2) && rep_ == 0;
            SchedGrid S{NTOK / 256 - pm0, 4, F.G, F.bid, pm0, (const char*)WSP(bf16_t, WS_M), (const char*)(WSP(bf16_t, WS_WOUT) + (size_t)li_ * 1024 * 1024), (size_t)256 * 2048, (size_t)256 * 2048};
            EpiOut E{WSP(bf16_t, WS_MACC), WSP(float, WS_MOD) + (size_t)li_ * 17 * 6144}; (void)dry;
            pg8::gemm_phase(F.lds, 1024, 2048u, 2048u, S, E);
        } SEAM(pb + 4);
        if (IN(pb + 5)) REPEAT(5) { p5_rows(F, li, row_lo, (NREP(5) == 2) && rep_ == 0); } SEAM(pb + 5);
        if (IN(pb + 6)) REPEAT(7) {
            int li_ = li; LAUNDER_S(li_);
            LAS int* tstart = (LAS int*)(F.lds + XTRA_OFF);
            LAS unsigned short* toks = (LAS unsigned short*)(F.lds + XTRA_OFF + 256);
            moe_tstart(F, li_, tstart);
            moe_toks(F, li_, tstart, toks, 8);
            SchedMoe S{tstart, toks, 8, F.G, F.bid, (const char*)WSP(bf16_t, WS_H), (const char*)(WSP(bf16_t, WS_WGU) + (size_t)li_ * 32 * 2048 * 1024), (size_t)0, (size_t)256 * 2048, (size_t)2048 * 2048};
            EpiGU E{WSP(bf16_t, WS_HID), F.in[34] + (size_t)li_ * 32 * 2048};
            pg8::gemm_phase(F.lds, 1024, 2048u, 2048u, S, E);
        } SEAM(pb + 6);
        if (IN(pb + 7)) REPEAT(8) {
            int li_ = li; LAUNDER_S(li_);
            LAS int* tstart = (LAS int*)(F.lds + XTRA_OFF);
            moe_tstart(F, li_, tstart);
            SchedMoe S{tstart, nullptr, 4, F.G, F.bid, (const char*)WSP(bf16_t, WS_HID), (const char*)(WSP(bf16_t, WS_WD) + (size_t)li_ * 32 * 1024 * 1024), (size_t)256 * 2048, (size_t)256 * 2048, (size_t)1024 * 2048};
            EpiDown E{WSP(unsigned char, WS_Y2), F.in[36] + (size_t)li_ * 32 * 1024, WSP(int, WS_ELIST), WSP(unsigned, WS_CTL) + CW_ECNT + li_ * 32 * 64};
            pg8::gemm_phase(F.lds, 1024, 2048u, 2048u, S, E);
        } SEAM(pb + 7);
        if (IN(pb + 8)) REPEAT(9) { p9_rows(F, li, row_lo, (NREP(9) == 2) && rep_ == 0); } SEAM(pb + 8);
    }
#undef IN
#undef SEAM
}

extern "C" void kernel_launch(void* const* d_in, const int* in_sizes, int n_in, void* d_out, int out_size, void* d_ws, size_t ws_size, hipStream_t stream) {
    static int grid = 0;
    if (grid == 0) {
        if (n_in != 37 || out_size != NLAT * D || ws_size < WS_END) { fprintf(stderr, "kernel_launch: unexpected shapes (n_in %d, out %d, ws %zu < %zu)\n", n_in, out_size, ws_size, (size_t)WS_END); grid = -1; return; }
        int dev = 0, cus = 0, per_cu = 0;
        if (hipGetDevice(&dev) != hipSuccess || hipDeviceGetAttribute(&cus, hipDeviceAttributeMultiprocessorCount, dev) != hipSuccess) { grid = -1; return; }
        if (hipFuncSetAttribute((const void*)fwd_kernel, hipFuncAttributeMaxDynamicSharedMemorySize, LDS_BYTES) != hipSuccess) { fprintf(stderr, "kernel_launch: hipFuncSetAttribute failed\n"); grid = -1; return; }
        if (hipOccupancyMaxActiveBlocksPerMultiprocessor(&per_cu, (const void*)fwd_kernel, NTHREADS, LDS_BYTES) != hipSuccess || per_cu < 1) { fprintf(stderr, "kernel_launch: occupancy query says %d\n", per_cu); }
        (void)hipGetLastError();
        grid = cus;
        if (grid != 256) fprintf(stderr, "kernel_launch: %d CUs (built for 256)\n", grid);
    }
    if (grid < 0) return;
    (void)hipMemsetAsync((char*)d_ws + WS_CTL, 0, CTL_BYTES, stream);
    Args a{};
    for (int i = 0; i < 37; ++i) a.in[i] = (const float*)d_in[i];
    a.out = (float*)d_out; a.ws = (unsigned char*)d_ws;
#if MK_N_LAUNCHES == 1
    a.ph_lo = 0; a.ph_hi = NPH;
    hipLaunchKernelGGL(fwd_kernel, dim3(grid), dim3(NTHREADS), LDS_BYTES, stream, a);
#else
    for (int p = 0; p < NPH; ++p) { a.ph_lo = p; a.ph_hi = p + 1; hipLaunchKernelGGL(fwd_kernel, dim3(grid), dim3(NTHREADS), LDS_BYTES, stream, a); }
#endif
    const hipError_t le = hipPeekAtLastError();
    if (le != hipSuccess) fprintf(stderr, "kernel_launch: launch failed: %s\n", hipGetErrorName(le));
}
```
